# Optimizing an MI355X kernel written in HIP

```python
import jax, jax.numpy as jnp
from jax import lax
import numpy as np

D_MODEL = 2048
BATCH = 2
SEQ = 8192
DEPTH = 4

MIX_WIDTH = D_MODEL
BLOCK = 128
WINDOW = 128
SWA_HEAD_DIM = 64
SWA_Q_HEADS = (MIX_WIDTH // 2) // SWA_HEAD_DIM
SWA_GROUP = 4
SWA_KV_HEADS = SWA_Q_HEADS // SWA_GROUP
MLA_NOPE_DIM = 128
MLA_ROPE_DIM = 64
MLA_QK_DIM = MLA_NOPE_DIM + MLA_ROPE_DIM
MLA_V_DIM = 128
MLA_HEADS = (MIX_WIDTH // 2) // MLA_V_DIM
MLA_Q_RANK = D_MODEL // 4
MLA_KV_RANK = D_MODEL // 8
ROPE_THETA = 10000.0
D_FF = 5632
PLE_DIM = 256
EPS = 1e-6

SWA_Q_COLS = SWA_Q_HEADS * SWA_HEAD_DIM
SWA_KV_COLS = SWA_KV_HEADS * SWA_HEAD_DIM
_SIZES = (SWA_Q_COLS, SWA_KV_COLS, SWA_KV_COLS, MLA_Q_RANK, MLA_KV_RANK, MLA_ROPE_DIM)
IN_COLS = sum(_SIZES)
IN_SPLITS = tuple(int(v) for v in np.cumsum(_SIZES)[:-1])

kernel_name = "hybrid_swa_sink_mla_macaron_ple"


def rms_norm(x, g):
    xf = x.astype(jnp.float32)
    y = xf * lax.rsqrt(jnp.mean(xf * xf, axis=-1, keepdims=True) + EPS)
    return (y * g.astype(jnp.float32)).astype(x.dtype)


def swiglu(x, w_gate, w_up, w_down):
    return (jax.nn.silu(x @ w_gate) * (x @ w_up)) @ w_down


def alibi_slopes(n_heads):
    h = np.arange(1, n_heads + 1, dtype=np.float32)
    return jnp.asarray(2.0 ** (-8.0 * h / n_heads), dtype=jnp.float32)


def apply_rope(x, positions):
    half = x.shape[-1] // 2
    inv_freq = ROPE_THETA ** (-jnp.arange(half, dtype=jnp.float32) / half)
    ang = positions.astype(jnp.float32)[:, :, None] * inv_freq
    cos = jnp.cos(ang)[:, :, None, :]
    sin = jnp.sin(ang)[:, :, None, :]
    xf = x.astype(jnp.float32)
    x1, x2 = xf[..., :half], xf[..., half:]
    return jnp.concatenate([x1 * cos - x2 * sin, x2 * cos + x1 * sin], axis=-1).astype(x.dtype)


def _with_prev_block(t, nb):
    tb = t.reshape(t.shape[0], nb, BLOCK, *t.shape[2:])
    prev = jnp.pad(tb[:, :-1], [(0, 0), (1, 0)] + [(0, 0)] * (tb.ndim - 2))
    return jnp.concatenate([prev, tb], axis=2)


def sliding_window_attention(q, k, v, positions, sinks):
    B, S = q.shape[0], q.shape[1]
    nb = S // BLOCK
    qb = q.reshape(B, nb, BLOCK, SWA_KV_HEADS, SWA_GROUP, SWA_HEAD_DIM)
    kb = _with_prev_block(k, nb)
    vb = _with_prev_block(v, nb)
    pk = _with_prev_block(positions, nb)
    pq = positions.reshape(B, nb, BLOCK)
    s = jnp.einsum('bnqhgd,bnkhd->bnhgqk', qb, kb,
                   preferred_element_type=jnp.float32) * (SWA_HEAD_DIM ** -0.5)
    dist = jnp.abs(pq[..., :, None] - pk[..., None, :]).astype(jnp.float32)
    slopes = alibi_slopes(SWA_Q_HEADS).reshape(SWA_KV_HEADS, SWA_GROUP)
    s = s - slopes[None, None, :, :, None, None] * dist[:, :, None, None]
    qi = jnp.arange(BLOCK)[:, None]
    kj = jnp.arange(2 * BLOCK)[None, :]
    diff = qi + BLOCK - kj
    band = (diff >= 0) & (diff < WINDOW)
    exists = (jnp.arange(nb)[:, None, None] > 0) | (kj[None] >= BLOCK)
    valid = band[None] & exists
    s = jnp.where(valid[None, :, None, None], s, -jnp.inf)
    sink = sinks.astype(jnp.float32).reshape(SWA_KV_HEADS, SWA_GROUP)[None, None, :, :, None, None]
    m = jnp.maximum(jnp.max(s, axis=-1, keepdims=True), sink)
    e = jnp.exp(s - m)
    probs = e / (jnp.sum(e, axis=-1, keepdims=True) + jnp.exp(sink - m))
    o = jnp.einsum('bnhgqk,bnkhd->bnqhgd', probs.astype(v.dtype), vb)
    return o.reshape(B, S, SWA_Q_HEADS * SWA_HEAD_DIM)


def causal_block_attention(q, k, v):
    B, S = q.shape[0], q.shape[1]
    nb = S // BLOCK
    qb = jnp.moveaxis(q.reshape(B, nb, BLOCK, MLA_HEADS, MLA_QK_DIM), 1, 0)
    kidx = jnp.arange(S)
    scale = MLA_QK_DIM ** -0.5

    def one_block(args):
        qblk, n = args
        s = jnp.einsum('bqhd,bkhd->bhqk', qblk, k, preferred_element_type=jnp.float32) * scale
        qidx = n * BLOCK + jnp.arange(BLOCK)
        s = jnp.where(kidx[None, :] <= qidx[:, None], s, -jnp.inf)
        probs = jax.nn.softmax(s, axis=-1)
        return jnp.einsum('bhqk,bkhd->bqhd', probs.astype(v.dtype), v)

    o = lax.map(one_block, (qb, jnp.arange(nb)))
    return jnp.moveaxis(o, 0, 1).reshape(B, S, MLA_HEADS * MLA_V_DIM)


def setup_inputs(seed: int = 0) -> dict:
    key = jax.random.key(seed)
    ks = iter(jax.random.split(key, 40))
    f32 = jnp.float32

    def w(shape, fan_in):
        return jax.random.normal(next(ks), shape, f32) * (fan_in ** -0.5)

    def gain(dim):
        return 1.0 + 0.05 * jax.random.normal(next(ks), (DEPTH, dim), f32)

    x = jax.random.normal(next(ks), (BATCH, SEQ, D_MODEL), f32)
    p = jax.random.normal(next(ks), (DEPTH, BATCH, SEQ, PLE_DIM), f32)
    offset = jax.random.randint(next(ks), (BATCH, 1), 0, 1024, dtype=jnp.int32)
    positions = (offset + jnp.arange(SEQ, dtype=jnp.int32)[None, :]).astype(jnp.int32)
    return {
        "x": x,
        "p": p,
        "positions": positions,
        "ffn1_norm": gain(D_MODEL),
        "ffn1_w_gate": w((DEPTH, D_MODEL, D_FF), D_MODEL),
        "ffn1_w_up": w((DEPTH, D_MODEL, D_FF), D_MODEL),
        "ffn1_w_down": w((DEPTH, D_FF, D_MODEL), D_FF),
        "mix_norm": gain(D_MODEL),
        "w_in": w((DEPTH, D_MODEL, IN_COLS), D_MODEL),
        "swa_q_norm": gain(SWA_HEAD_DIM),
        "swa_k_norm": gain(SWA_HEAD_DIM),
        "swa_sinks": 0.5 * jax.random.normal(next(ks), (DEPTH, SWA_Q_HEADS), f32),
        "mla_q_lora_norm": gain(MLA_Q_RANK),
        "mla_w_uq": w((DEPTH, MLA_Q_RANK, MLA_HEADS * MLA_QK_DIM), MLA_Q_RANK),
        "mla_kv_lora_norm": gain(MLA_KV_RANK),
        "mla_w_ukv": w((DEPTH, MLA_KV_RANK, MLA_HEADS * (MLA_NOPE_DIM + MLA_V_DIM)), MLA_KV_RANK),
        "mla_q_norm": gain(MLA_QK_DIM),
        "mla_k_norm": gain(MLA_QK_DIM),
        "out_norm_swa": gain(SWA_Q_COLS),
        "out_norm_mla": gain(MLA_HEADS * MLA_V_DIM),
        "w_o": w((DEPTH, MIX_WIDTH, D_MODEL), MIX_WIDTH),
        "ffn2_norm": gain(D_MODEL),
        "ffn2_w_gate": w((DEPTH, D_MODEL, D_FF), D_MODEL),
        "ffn2_w_up": w((DEPTH, D_MODEL, D_FF), D_MODEL),
        "ffn2_w_down": w((DEPTH, D_FF, D_MODEL), D_FF),
        "ple_proj": w((DEPTH, PLE_DIM, D_MODEL), PLE_DIM),
        "ple_proj_norm": gain(D_MODEL),
        "ple_gate_norm": gain(D_MODEL),
        "ple_gate": w((DEPTH, D_MODEL, D_MODEL), D_MODEL),
    }


def reference(x, p, positions, ffn1_norm, ffn1_w_gate, ffn1_w_up, ffn1_w_down,
              mix_norm, w_in, swa_q_norm, swa_k_norm, swa_sinks,
              mla_q_lora_norm, mla_w_uq, mla_kv_lora_norm, mla_w_ukv, mla_q_norm, mla_k_norm,
              out_norm_swa, out_norm_mla, w_o,
              ffn2_norm, ffn2_w_gate, ffn2_w_up, ffn2_w_down,
              ple_proj, ple_proj_norm, ple_gate_norm, ple_gate):
    B, S = x.shape[0], x.shape[1]
    for i in range(DEPTH):
        h = x + 0.5 * swiglu(rms_norm(x, ffn1_norm[i]), ffn1_w_gate[i], ffn1_w_up[i], ffn1_w_down[i])

        n = rms_norm(h, mix_norm[i])
        z = n @ w_in[i]
        q_a, k_a, v_a, c_q, c_kv, k_r = jnp.split(z, IN_SPLITS, axis=-1)

        q_a = rms_norm(q_a.reshape(B, S, SWA_Q_HEADS, SWA_HEAD_DIM), swa_q_norm[i])
        k_a = rms_norm(k_a.reshape(B, S, SWA_KV_HEADS, SWA_HEAD_DIM), swa_k_norm[i])
        v_a = v_a.reshape(B, S, SWA_KV_HEADS, SWA_HEAD_DIM)
        o_a = sliding_window_attention(q_a, k_a, v_a, positions, swa_sinks[i])

        q_b = (rms_norm(c_q, mla_q_lora_norm[i]) @ mla_w_uq[i]).reshape(B, S, MLA_HEADS, MLA_QK_DIM)
        kv = (rms_norm(c_kv, mla_kv_lora_norm[i]) @ mla_w_ukv[i]).reshape(
            B, S, MLA_HEADS, MLA_NOPE_DIM + MLA_V_DIM)
        k_nope, v_b = kv[..., :MLA_NOPE_DIM], kv[..., MLA_NOPE_DIM:]
        k_rope = jnp.broadcast_to(k_r[:, :, None, :], (B, S, MLA_HEADS, MLA_ROPE_DIM))
        k_b = jnp.concatenate([k_nope, k_rope], axis=-1)
        q_b = rms_norm(q_b, mla_q_norm[i])
        k_b = rms_norm(k_b, mla_k_norm[i])
        q_b = jnp.concatenate([q_b[..., :MLA_NOPE_DIM], apply_rope(q_b[..., MLA_NOPE_DIM:], positions)], axis=-1)
        k_b = jnp.concatenate([k_b[..., :MLA_NOPE_DIM], apply_rope(k_b[..., MLA_NOPE_DIM:], positions)], axis=-1)
        o_b = causal_block_attention(q_b, k_b, v_b)

        mixed = jnp.concatenate([rms_norm(o_a, out_norm_swa[i]), rms_norm(o_b, out_norm_mla[i])], axis=-1)
        h = h + mixed @ w_o[i]

        h = h + 0.5 * swiglu(rms_norm(h, ffn2_norm[i]), ffn2_w_gate[i], ffn2_w_up[i], ffn2_w_down[i])

        gate = jax.nn.sigmoid(rms_norm(h, ple_gate_norm[i]) @ ple_gate[i])
        x = h + rms_norm(p[i] @ ple_proj[i], ple_proj_norm[i]) * gate
    return x
```

```cpp
#include <hip/hip_runtime.h>
#include <cstdio>
#include <cstdint>
#include <cmath>
namespace pg8 {
#define PG8_LAS __attribute__((address_space(3)))
typedef unsigned short bf16_t;
typedef short bf16x8 __attribute__((ext_vector_type(8)));
typedef float f32x4 __attribute__((ext_vector_type(4)));
typedef unsigned u32x4 __attribute__((ext_vector_type(4)));
constexpr int BM = 256, BK = 64, HALF = 128, HTB = HALF * BK * 2  , STAGE_BYTES = 8 * HTB, NXCD = 8, WGM = 8;

__host__ __device__ __forceinline__ int lds_byte(int r, int c) { const int st = (r >> 4) * 2 + (c >> 5), rr = r & 15, cc = c & 31, ob = rr * 64 + cc * 2; return st * 1024 + (ob ^ (((ob >> 9) & 1) << 5)); }
__host__ __device__ __forceinline__ void stage_rc(int b, int& R, int& C) { const int st = b / 1024, sb = b % 1024, swz = sb ^ (((sb >> 9) & 1) << 5); R = (st >> 1) * 16 + swz / 64; C = (st & 1) * 32 + (swz % 64) / 2; }
__host__ __device__ __forceinline__ int perm32(int rho) { const int n = rho >> 4, i = rho & 15; return 8 * (i >> 2) + 4 * n + (i & 3); }

struct Unit { int pm, pn; };
struct Gemm { const bf16_t* A; const bf16_t* Bt; int M, N, K; };

struct StaticOrder {
    int nM, nN, nwg, G, c;
    __host__ __device__ void init(int M, int N, int G_, int c_) { nM = M / BM; nN = N / BM; nwg = nM * nN; G = G_; c = c_; }
    __host__ __device__ bool next(int i, Unit& u) const {
        const long L = (long)i * G + c; if (L >= nwg) return false;
        int wgid = (int)L; { const int q = nwg / NXCD, r = nwg % NXCD, xcd = wgid % NXCD, off = wgid / NXCD; wgid = (xcd < r ? xcd * (q + 1) : r * (q + 1) + (xcd - r) * q) + off; }
        const int nig = WGM * nN, gid = wgid / nig, fm = gid * WGM, gsz = (nM - fm) < WGM ? (nM - fm) : WGM;
        u.pm = fm + ((wgid % nig) % gsz); u.pn = (wgid % nig) / gsz; return true;
    }
    __device__ __forceinline__ void a_ready(const Unit&) const {}
    __device__ __forceinline__ void done(const Unit&) const {}
};

__device__ __forceinline__ unsigned cvt_pk_bf16(float lo, float hi) { unsigned r; asm volatile("v_cvt_pk_bf16_f32 %0, %1, %2" : "=v"(r) : "v"(lo), "v"(hi)); return r; }
typedef float f32x2 __attribute__((ext_vector_type(2)));
template <class Epi, class Sched, bool ALIGN_EPI = false, bool SP2 = false>
__device__ __forceinline__ void gemm_phase(PG8_LAS unsigned char* lds, const Gemm g, const Sched& S, const Epi& E) {
    int tid_ = threadIdx.x; asm volatile("" : "+v"(tid_));
    const int tid = tid_, wid = __builtin_amdgcn_readfirstlane(tid >> 6), lane = tid & 63, wr = wid >> 2, wc = wid & 3, fr = lane & 15, fq = lane >> 4;
    const int K = g.K, nt = K / BK;
    unsigned voffA[2], voffB[2];
#pragma unroll
    for (int i = 0; i < 2; ++i) { int R, C; stage_rc(tid * 16 + i * 8192, R, C); const int Rb = Epi::PERM ? ((R & ~31) + perm32(R & 31)) : R;
        voffA[i] = (unsigned)(R * K + C) * 2u; voffB[i] = (unsigned)(Rb * K + C) * 2u; }
    const size_t kstep = (size_t)(BK * 2);
    const size_t hstep = (size_t)HALF * K * 2;
    const size_t tstep = 2 * hstep;
    const unsigned ldsw = (unsigned)wid * 1024u;
    const int aoff = lds_byte(wr * 64 + fr, fq * 8), boff = lds_byte(wc * 32 + fr, fq * 8);
#define PG8_SA(b, h) (((b) * 2 + (h)) * HTB)
#define PG8_SB(b, h) ((4 + (b) * 2 + (h)) * HTB)
#define PG8_STAGE(bufoff, gbase, voff) do { _Pragma("unroll") for (int _i = 0; _i < 2; ++_i) \
        __builtin_amdgcn_global_load_lds((const unsigned*)((const char*)(gbase) + (voff)[_i]), (PG8_LAS unsigned*)(lds + (bufoff) + ldsw + _i * 8192), 16, 0, 0); } while (0)
#define PG8_LDA(dst, b, h) do { _Pragma("unroll") for (int m = 0; m < 4; ++m) _Pragma("unroll") for (int k = 0; k < 2; ++k) dst[m][k] = *(const PG8_LAS bf16x8*)(lds + PG8_SA(b, h) + aoff + m * 2048 + k * 1024); } while (0)
#define PG8_LDB(dst, b, h) do { _Pragma("unroll") for (int n = 0; n < 2; ++n) _Pragma("unroll") for (int k = 0; k < 2; ++k) dst[n][k] = *(const PG8_LAS bf16x8*)(lds + PG8_SB(b, h) + boff + n * 2048 + k * 1024); } while (0)
#define PG8_MMA(ai, bj, At, Bt) do { __builtin_amdgcn_s_setprio(1); _Pragma("unroll") for (int m = 0; m < 4; ++m) _Pragma("unroll") for (int n = 0; n < 2; ++n) _Pragma("unroll") for (int k = 0; k < 2; ++k) \
        acc[ai][bj][m][n] = __builtin_amdgcn_mfma_f32_16x16x32_bf16(Bt[n][k], At[m][k], acc[ai][bj][m][n], 0, 0, 0); __builtin_amdgcn_s_setprio(0); } while (0)
#define PG8_WAIT_V(n) asm volatile("s_waitcnt vmcnt(" #n ")" ::: "memory")
#define PG8_WAIT_L(n) asm volatile("s_waitcnt lgkmcnt(" #n ")" ::: "memory")
#define PG8_BAR __builtin_amdgcn_s_barrier()
#define PG8_SCHED __builtin_amdgcn_sched_barrier(0)
    Unit cur, nxt; int ui = 0;
    if (!S.next(0, cur)) return;
    f32x4 acc[2][2][4][2];
#pragma unroll
    for (int a = 0; a < 2; ++a)
#pragma unroll
        for (int b = 0; b < 2; ++b)
#pragma unroll
            for (int m = 0; m < 4; ++m)
#pragma unroll
                for (int n = 0; n < 2; ++n) acc[a][b][m][n] = (f32x4){0.f, 0.f, 0.f, 0.f};
    bf16x8 At[4][2], B0[2][2], B1[2][2];
    const char* cA = (const char*)g.A + (size_t)cur.pm * tstep; const char* cB = (const char*)g.Bt + (size_t)cur.pn * tstep;
    S.a_ready(cur);
    if constexpr (SP2) {
        PG8_STAGE(PG8_SB(0, 0), cB, voffB); PG8_STAGE(PG8_SB(0, 1), cB + hstep, voffB); PG8_STAGE(PG8_SA(0, 0), cA, voffA); PG8_STAGE(PG8_SA(0, 1), cA + hstep, voffA);
        if (wr == 1) PG8_BAR;
        PG8_WAIT_V(2); PG8_BAR;
        PG8_STAGE(PG8_SB(1, 0), cB + kstep, voffB); PG8_STAGE(PG8_SA(1, 0), cA + kstep, voffA); PG8_STAGE(PG8_SB(1, 1), cB + hstep + kstep, voffB);
        PG8_WAIT_V(6); PG8_BAR;
    } else {
        PG8_STAGE(PG8_SB(0, 0), cB, voffB); PG8_STAGE(PG8_SA(0, 0), cA, voffA); PG8_STAGE(PG8_SB(0, 1), cB + hstep, voffB); PG8_STAGE(PG8_SA(0, 1), cA + hstep, voffA);
        if (wr == 1) PG8_BAR;
        PG8_WAIT_V(4); PG8_BAR;
        PG8_STAGE(PG8_SB(1, 0), cB + kstep, voffB); PG8_STAGE(PG8_SA(1, 0), cA + kstep, voffA); PG8_STAGE(PG8_SB(1, 1), cB + hstep + kstep, voffB);
        PG8_WAIT_V(6); PG8_BAR;
    }
    for (;;) {
        const bool has_next = S.next(ui + 1, nxt);
        const char* nA = has_next ? (const char*)g.A + (size_t)nxt.pm * tstep : cA; const char* nB = has_next ? (const char*)g.Bt + (size_t)nxt.pn * tstep : cB;
        for (int t = 0; t < nt; t += 2) {
            const bool last = (t == nt - 2);
            const char* a1 = cA + (size_t)(t + 1) * kstep;
            const char* a2 = last ? nA : cA + (size_t)(t + 2) * kstep; const char* b2 = last ? nB : cB + (size_t)(t + 2) * kstep;
            const char* a3 = a2 + kstep; const char* b3 = b2 + kstep;
            if (last && has_next) S.a_ready(nxt);
            if constexpr (SP2) {
            PG8_LDB(B0, 0, 0); PG8_LDB(B1, 0, 1); PG8_SCHED; PG8_LDA(At, 0, 0); PG8_STAGE(PG8_SA(1, 1), a1 + hstep, voffA);
            PG8_WAIT_V(8); PG8_WAIT_L(0); PG8_BAR; PG8_MMA(0, 0, At, B0); PG8_MMA(0, 1, At, B1); PG8_BAR; PG8_SCHED;
            PG8_LDA(At, 0, 1); PG8_STAGE(PG8_SB(0, 0), b2, voffB); PG8_STAGE(PG8_SB(0, 1), b2 + hstep, voffB); PG8_STAGE(PG8_SA(0, 0), a2, voffA);
            PG8_WAIT_V(8); PG8_WAIT_L(0); PG8_BAR; PG8_MMA(1, 0, At, B0); PG8_MMA(1, 1, At, B1); PG8_BAR; PG8_SCHED;
            PG8_LDB(B0, 1, 0); PG8_LDB(B1, 1, 1); PG8_SCHED; PG8_LDA(At, 1, 0); PG8_STAGE(PG8_SA(0, 1), a2 + hstep, voffA);
            PG8_WAIT_V(8); PG8_WAIT_L(0); PG8_BAR; PG8_MMA(0, 0, At, B0); PG8_MMA(0, 1, At, B1); PG8_BAR; PG8_SCHED;
            PG8_LDA(At, 1, 1); PG8_STAGE(PG8_SB(1, 0), b3, voffB); PG8_STAGE(PG8_SB(1, 1), b3 + hstep, voffB); PG8_STAGE(PG8_SA(1, 0), a3, voffA);
            PG8_WAIT_V(8); PG8_WAIT_L(0); PG8_BAR; PG8_MMA(1, 0, At, B0); PG8_MMA(1, 1, At, B1); PG8_BAR; PG8_SCHED;
            } else {
            PG8_LDB(B0, 0, 0); PG8_SCHED; PG8_LDA(At, 0, 0); PG8_STAGE(PG8_SA(1, 1), a1 + hstep, voffA);
            PG8_WAIT_L(8); PG8_BAR; PG8_WAIT_L(0); PG8_MMA(0, 0, At, B0); PG8_BAR; PG8_SCHED;
            PG8_LDB(B1, 0, 1); PG8_STAGE(PG8_SB(0, 0), b2, voffB);
            PG8_BAR; PG8_WAIT_L(0); PG8_MMA(0, 1, At, B1); PG8_BAR;
            PG8_LDA(At, 0, 1); PG8_STAGE(PG8_SA(0, 0), a2, voffA);
            PG8_BAR; PG8_WAIT_L(0); PG8_MMA(1, 0, At, B0); PG8_BAR; PG8_SCHED;
            PG8_STAGE(PG8_SB(0, 1), b2 + hstep, voffB);
            PG8_WAIT_V(6); PG8_BAR; PG8_MMA(1, 1, At, B1); PG8_BAR;
            PG8_LDB(B0, 1, 0); PG8_SCHED; PG8_LDA(At, 1, 0); PG8_STAGE(PG8_SA(0, 1), a2 + hstep, voffA);
            PG8_WAIT_L(8); PG8_BAR; PG8_WAIT_L(0); PG8_MMA(0, 0, At, B0); PG8_BAR; PG8_SCHED;
            PG8_LDB(B1, 1, 1); PG8_STAGE(PG8_SB(1, 0), b3, voffB);
            PG8_BAR; PG8_WAIT_L(0); PG8_MMA(0, 1, At, B1); PG8_BAR;
            PG8_LDA(At, 1, 1); PG8_STAGE(PG8_SA(1, 0), a3, voffA);
            PG8_BAR; PG8_WAIT_L(0); PG8_MMA(1, 0, At, B0); PG8_BAR; PG8_SCHED;
            PG8_STAGE(PG8_SB(1, 1), b3 + hstep, voffB);
            PG8_WAIT_V(6); PG8_BAR; PG8_MMA(1, 1, At, B1); PG8_BAR;
            }
        }
        if constexpr (ALIGN_EPI) { if (wr == 0) PG8_BAR; }
        if constexpr (!Epi::AFTER_DRAIN) { E(acc, cur, wr, wc, fr, fq); S.done(cur); }
        if (!has_next) break;
#pragma unroll
        for (int a = 0; a < 2; ++a)
#pragma unroll
            for (int b = 0; b < 2; ++b)
#pragma unroll
                for (int m = 0; m < 4; ++m)
#pragma unroll
                    for (int n = 0; n < 2; ++n) acc[a][b][m][n] = (f32x4){0.f, 0.f, 0.f, 0.f};
        cur = nxt; cA = nA; cB = nB; ++ui;
        if constexpr (ALIGN_EPI) { if (wr == 1) PG8_BAR; }
    }
    PG8_WAIT_V(0);
    if constexpr (!ALIGN_EPI) { if (wr == 0) PG8_BAR; }
    PG8_BAR;
    if constexpr (Epi::AFTER_DRAIN) { E.fused(acc, cur, wr, wc, fr, fq, lds, wid, lane); S.done(cur); }
#undef PG8_SA
#undef PG8_SB
#undef PG8_STAGE
#undef PG8_LDA
#undef PG8_LDB
#undef PG8_MMA
#undef PG8_WAIT_V
#undef PG8_WAIT_L
#undef PG8_BAR
#undef PG8_SCHED
}
}
constexpr int BATCH = 2, SEQ = 8192, MROWS = BATCH * SEQ, DM = 2048, DFF = 5632, DEPTH = 4, PLE = 256;
constexpr int NIN = 2560;
constexpr int QB_PITCH = 1536, KB_PITCH = 1536, VB_PITCH = 1024, QA_PITCH = 1024, KA_PITCH = 256, VA_PITCH = 256;
constexpr float EPS = 1e-6f, LOG2E = 1.4426950408889634f;
constexpr float QA_SCALE = 0.125f * LOG2E;
constexpr float QB_SCALE = 0.07216878364870322f * LOG2E;

constexpr size_t MiB = 1u << 20;
constexpr size_t WS_CTL = 0;
constexpr size_t ZERO_BYTES = 1 * MiB;
constexpr size_t WS_SSKR = 4 * MiB;
constexpr size_t WS_KRR = 5 * MiB;
constexpr size_t WS_ROPEC = 9 * MiB, WS_ROPES = 11 * MiB;
constexpr size_t WS_HB = 13 * MiB;
constexpr size_t WS_U = 77 * MiB;
constexpr size_t WS_QA = 253 * MiB, WS_KA = 285 * MiB, WS_VA = 293 * MiB, WS_CQ = 301 * MiB, WS_CKV = 317 * MiB;
constexpr size_t WS_QB = 325 * MiB, WS_KB = 373 * MiB, WS_VB = 421 * MiB, WS_O = 453 * MiB, WS_PP = 517 * MiB, WS_PB = 581 * MiB;
constexpr size_t WS_W = 613 * MiB;
constexpr size_t W_1GU = 0, W_1D = 44 * MiB, W_IN = 66 * MiB, W_UQ = 76 * MiB, W_UKV = 78 * MiB, W_O = 79 * MiB, W_2GU = 87 * MiB, W_2D = 131 * MiB, W_PG = 153 * MiB, W_PP = 161 * MiB, W_LAYER = 162 * MiB;
constexpr size_t WS_HB2 = WS_W + DEPTH * W_LAYER;
constexpr size_t WS_STATS = WS_HB2 + 64 * MiB;
constexpr size_t WS_END = WS_STATS + 16 * MiB;
static_assert((size_t)11264 * 2048 * 2 == 44 * MiB && (size_t)2048 * 5632 * 2 == 22 * MiB && (size_t)NIN * 2048 * 2 == 10 * MiB, "weight sizes");
enum { SS_IN = 0, SS_1 = 1, SS_CQ = 2, SS_CKV = 3, SS_2 = 4, SS_3 = 5, SS_PP = 6 };
typedef __attribute__((address_space(4))) const unsigned long long* KArg;
constexpr int KA_OUT = 29, KA_WS = 30;
__device__ __forceinline__ KArg ka_fresh(KArg k) { asm volatile("" : "+s"(k)); return k; }
template <class T> __device__ __forceinline__ T* ka_ptr(KArg k, int i) { return (T*)(__attribute__((address_space(1))) T*)k[i]; }
__device__ __forceinline__ float* ka_stats(KArg k, int slot) { return (float*)(ka_ptr<unsigned char>(k, KA_WS) + WS_STATS) + (size_t)slot * MROWS * 32; }

namespace pg8 {
typedef float f32x2 __attribute__((ext_vector_type(2)));
typedef unsigned u32x2 __attribute__((ext_vector_type(2)));
__device__ __forceinline__ float rsq(float x) { return __builtin_amdgcn_rsqf(x); }
__device__ __forceinline__ float dot4(f32x4 a) { return (a[0] * a[0] + a[1] * a[1]) + (a[2] * a[2] + a[3] * a[3]); }
__device__ __forceinline__ u32x4 pack8(f32x4 a, f32x4 b) { u32x4 w; w.x = cvt_pk_bf16(a[0], a[1]); w.y = cvt_pk_bf16(a[2], a[3]); w.z = cvt_pk_bf16(b[0], b[1]); w.w = cvt_pk_bf16(b[2], b[3]); return w; }
__device__ __forceinline__ float silu1(float x) { return x * __builtin_amdgcn_rcpf(1.0f + __builtin_amdgcn_exp2f(-x * LOG2E)); }
__device__ __forceinline__ float sigm1(float x) { return __builtin_amdgcn_rcpf(1.0f + __builtin_amdgcn_exp2f(-x * LOG2E)); }
__device__ __forceinline__ float bf_lo(unsigned w) { return __uint_as_float(w << 16); }
__device__ __forceinline__ float bf_hi(unsigned w) { return __uint_as_float(w & 0xffff0000u); }
__device__ __forceinline__ float ssq32(const float* slot, int row, int fq) { const f32x4 a = *(const f32x4*)(slot + (size_t)row * 32 + fq * 8), b = *(const f32x4*)(slot + (size_t)row * 32 + fq * 8 + 4);
    float s = ((a[0] + a[1]) + (a[2] + a[3])) + ((b[0] + b[1]) + (b[2] + b[3])); s += __shfl_xor(s, 16); s += __shfl_xor(s, 32); return s; }
__device__ __forceinline__ float rowsum_fq(float s) { s += __shfl_xor(s, 16); s += __shfl_xor(s, 32); return s; }


struct EpiSwiGLU {
    static constexpr bool PERM = true, AFTER_DRAIN = false;
    KArg ka; int slot_in;
    __device__ __forceinline__ void operator()(const f32x4 (&acc)[2][2][4][2], const Unit& u, int wr, int wc_, int fr_, int fq_) const {
        int fr = fr_, fq = fq_, wc = wc_; asm volatile("" : "+v"(fr), "+v"(fq), "+s"(wc));
        const int row0 = u.pm * BM + wr * 64 + fr, col0 = u.pn * 128 + wc * 32 + 8 * fq;
        const KArg k = ka_fresh(ka); bf16_t* U = (bf16_t*)(ka_ptr<unsigned char>(k, KA_WS) + WS_U); const float* ssq = ka_stats(k, slot_in);
#pragma unroll
        for (int ai = 0; ai < 2; ++ai)
#pragma unroll
            for (int m = 0; m < 4; ++m) { const int row = row0 + ai * HALF + m * 16; const float rs = rsq(ssq32(ssq, row, fq) * (1.0f / DM) + EPS);
                f32x4 o[2];
#pragma unroll
                for (int n = 0; n < 2; ++n) { const f32x4 g = acc[ai][0][m][n] * rs, up = acc[ai][1][m][n] * rs;
                    o[n] = (f32x4){silu1(g[0]) * up[0], silu1(g[1]) * up[1], silu1(g[2]) * up[2], silu1(g[3]) * up[3]}; }
                *(u32x4*)(U + (size_t)row * DFF + col0) = pack8(o[0], o[1]); }
    }
};
struct EpiResid {
    static constexpr bool PERM = true, AFTER_DRAIN = false;
    KArg ka; int slot_out; float scale;
    __device__ __forceinline__ void operator()(const f32x4 (&acc)[2][2][4][2], const Unit& u, int wr, int wc_, int fr_, int fq_) const {
        int fr = fr_, fq = fq_, wc = wc_; asm volatile("" : "+v"(fr), "+v"(fq), "+s"(wc));
        const int row0 = u.pm * BM + wr * 64 + fr, col0 = u.pn * BM + wc * 32 + 8 * fq;
        const KArg k = ka_fresh(ka); float* X = ka_ptr<float>(k, KA_OUT); bf16_t* HB = (bf16_t*)(ka_ptr<unsigned char>(k, KA_WS) + WS_HB); float* ssq_out = ka_stats(k, slot_out);
#pragma unroll
        for (int ai = 0; ai < 2; ++ai)
#pragma unroll
            for (int m = 0; m < 4; ++m) { const int row = row0 + ai * HALF + m * 16; float part = 0.f;
#pragma unroll
                for (int bj = 0; bj < 2; ++bj) { float* xp = X + (size_t)row * DM + col0 + bj * HALF;
                    f32x4 x0 = *(const f32x4*)xp, x1 = *(const f32x4*)(xp + 4);
                    x0 = x0 + acc[ai][bj][m][0] * scale; x1 = x1 + acc[ai][bj][m][1] * scale;
                    *(f32x4*)xp = x0; *(f32x4*)(xp + 4) = x1;
                    *(u32x4*)(HB + (size_t)row * DM + col0 + bj * HALF) = pack8(x0, x1);
                    part += dot4(x0) + dot4(x1); }
                part = rowsum_fq(part);
                if (fq == 0) ssq_out[(size_t)row * 32 + u.pn * 4 + wc] = part; }
    }
};
struct EpiStoreSsq {
    static constexpr bool PERM = true, AFTER_DRAIN = false;
    KArg ka; int slot_out;
    __device__ __forceinline__ void operator()(const f32x4 (&acc)[2][2][4][2], const Unit& u, int wr, int wc_, int fr_, int fq_) const {
        int fr = fr_, fq = fq_, wc = wc_; asm volatile("" : "+v"(fr), "+v"(fq), "+s"(wc));
        const int row0 = u.pm * BM + wr * 64 + fr, col0 = u.pn * BM + wc * 32 + 8 * fq;
        const KArg k = ka_fresh(ka); bf16_t* O = (bf16_t*)(ka_ptr<unsigned char>(k, KA_WS) + WS_PP); constexpr int ldc = DM; float* ssq_out = ka_stats(k, slot_out);
#pragma unroll
        for (int ai = 0; ai < 2; ++ai)
#pragma unroll
            for (int m = 0; m < 4; ++m) { const int row = row0 + ai * HALF + m * 16; float part = 0.f;
#pragma unroll
                for (int bj = 0; bj < 2; ++bj) { const f32x4 v0 = acc[ai][bj][m][0], v1 = acc[ai][bj][m][1];
                    *(u32x4*)(O + (size_t)row * ldc + col0 + bj * HALF) = pack8(v0, v1); part += dot4(v0) + dot4(v1); }
                part = rowsum_fq(part);
                if (fq == 0) ssq_out[(size_t)row * 32 + u.pn * 4 + wc] = part; }
    }
};
struct EpiWin {
    static constexpr bool PERM = true, AFTER_DRAIN = false;
    KArg ka; int l;
    __device__ __forceinline__ void operator()(const f32x4 (&acc)[2][2][4][2], const Unit& u, int wr, int wc_, int fr_, int fq_) const {
        int fr = fr_, fq = fq_, wc = wc_; asm volatile("" : "+v"(fr), "+v"(fq), "+s"(wc));
        const int row0 = u.pm * BM + wr * 64 + fr, pn = u.pn;
        const KArg k = ka_fresh(ka); unsigned char* ws = ka_ptr<unsigned char>(k, KA_WS); const float* ssq_in = ka_stats(k, SS_1);
        if (pn <= 4) {
            const float* gq = ka_ptr<const float>(k, 9) + l * 64; const float* gk = ka_ptr<const float>(k, 10) + l * 64; bf16_t* QA = (bf16_t*)(ws + WS_QA); bf16_t* KA = (bf16_t*)(ws + WS_KA);
            const float* gain = pn < 4 ? gq : gk; const float extra = pn < 4 ? QA_SCALE : 1.0f;
            bf16_t* dst = pn < 4 ? QA + (4 * pn + wc) * 64 : KA + wc * 64; const int pitch = pn < 4 ? QA_PITCH : KA_PITCH;
            f32x4 g[2][2];
#pragma unroll
            for (int bj = 0; bj < 2; ++bj)
#pragma unroll
                for (int n = 0; n < 2; ++n) g[bj][n] = *(const f32x4*)(gain + 32 * bj + 8 * fq + 4 * n);
#pragma unroll
            for (int ai = 0; ai < 2; ++ai)
#pragma unroll
                for (int m = 0; m < 4; ++m) { const int row = row0 + ai * HALF + m * 16; const float rs = rsq(ssq32(ssq_in, row, fq) * (1.0f / DM) + EPS);
                    float ss = 0.f;
#pragma unroll
                    for (int bj = 0; bj < 2; ++bj)
#pragma unroll
                        for (int n = 0; n < 2; ++n) ss += dot4(acc[ai][bj][m][n]);
                    ss = rowsum_fq(ss) * rs * rs;
                    const float sc = rsq(ss * (1.0f / 64.0f) + EPS) * extra * rs;
#pragma unroll
                    for (int bj = 0; bj < 2; ++bj)
                        *(u32x4*)(dst + (size_t)row * pitch + 32 * bj + 8 * fq) = pack8(acc[ai][bj][m][0] * sc * g[bj][0], acc[ai][bj][m][1] * sc * g[bj][1]); }
        } else if (pn <= 8) {
            bf16_t* dst; int pitch; float* sq; bf16_t* VA = (bf16_t*)(ws + WS_VA); bf16_t* CQ = (bf16_t*)(ws + WS_CQ); bf16_t* CKV = (bf16_t*)(ws + WS_CKV);
            float* ssq_cq = ka_stats(k, SS_CQ); float* ssq_ckv = ka_stats(k, SS_CKV);
            if (pn == 5) { dst = VA; pitch = VA_PITCH; sq = nullptr; } else if (pn <= 7) { dst = CQ + (pn - 6) * 256; pitch = 512; sq = ssq_cq; } else { dst = CKV; pitch = 256; sq = ssq_ckv; }
#pragma unroll
            for (int ai = 0; ai < 2; ++ai)
#pragma unroll
                for (int m = 0; m < 4; ++m) { const int row = row0 + ai * HALF + m * 16; const float rs = rsq(ssq32(ssq_in, row, fq) * (1.0f / DM) + EPS); float part = 0.f;
#pragma unroll
                    for (int bj = 0; bj < 2; ++bj) { const f32x4 v0 = acc[ai][bj][m][0] * rs, v1 = acc[ai][bj][m][1] * rs;
                        *(u32x4*)(dst + (size_t)row * pitch + bj * HALF + wc * 32 + 8 * fq) = pack8(v0, v1); part += dot4(v0) + dot4(v1); }
                    part = rowsum_fq(part);
                    if (sq != nullptr && fq == 0) sq[(size_t)row * 32 + (pn == 7 ? 4 : 0) + wc] = part; }
        } else if (wc == 0) {
            const float* gkr = ka_ptr<const float>(k, 17) + l * 192 + 128; float* SSKR = (float*)(ws + WS_SSKR); float* KRR = (float*)(ws + WS_KRR);
            const float* ropec = (const float*)(ws + WS_ROPEC); const float* ropes = (const float*)(ws + WS_ROPES);
            f32x4 g1[2], g2[2];
#pragma unroll
            for (int n = 0; n < 2; ++n) { g1[n] = *(const f32x4*)(gkr + 8 * fq + 4 * n); g2[n] = *(const f32x4*)(gkr + 32 + 8 * fq + 4 * n); }
#pragma unroll
            for (int ai = 0; ai < 2; ++ai)
#pragma unroll
                for (int m = 0; m < 4; ++m) { const int row = row0 + ai * HALF + m * 16; const float rs = rsq(ssq32(ssq_in, row, fq) * (1.0f / DM) + EPS);
                    float ss = 0.f;
#pragma unroll
                    for (int bj = 0; bj < 2; ++bj)
#pragma unroll
                        for (int n = 0; n < 2; ++n) ss += dot4(acc[ai][bj][m][n]);
                    ss = rowsum_fq(ss) * rs * rs;
                    if (fq == 0) SSKR[row] = ss;
#pragma unroll
                    for (int n = 0; n < 2; ++n) { const f32x4 c = *(const f32x4*)(ropec + (size_t)row * 32 + 8 * fq + 4 * n), s = *(const f32x4*)(ropes + (size_t)row * 32 + 8 * fq + 4 * n);
                        const f32x4 x1 = acc[ai][0][m][n] * rs * g1[n], x2 = acc[ai][1][m][n] * rs * g2[n];
                        *(f32x4*)(KRR + (size_t)row * 64 + 8 * fq + 4 * n) = x1 * c - x2 * s;
                        *(f32x4*)(KRR + (size_t)row * 64 + 32 + 8 * fq + 4 * n) = x2 * c + x1 * s; } }
        }
    }
};
struct EpiQB {
    static constexpr bool PERM = true, AFTER_DRAIN = false;
    KArg ka; int l; PG8_LAS float* T;
    __device__ __forceinline__ void operator()(const f32x4 (&acc)[2][2][4][2], const Unit& u, int wr, int wc_, int fr_, int fq_) const {
        int fr = fr_, fq = fq_, wc = wc_; asm volatile("" : "+v"(fr), "+v"(fq), "+s"(wc));
        const int row0 = u.pm * BM + wr * 64 + fr, h = u.pn;
        const KArg k = ka_fresh(ka); unsigned char* ws = ka_ptr<unsigned char>(k, KA_WS); const float* ssq_cq = ka_stats(k, SS_CQ); const float* gqn = ka_ptr<const float>(k, 16) + l * 192;
        bf16_t* QB = (bf16_t*)(ws + WS_QB); const float* ropec = (const float*)(ws + WS_ROPEC); const float* ropes = (const float*)(ws + WS_ROPES);
        float rs[2][4];
#pragma unroll
        for (int ai = 0; ai < 2; ++ai)
#pragma unroll
            for (int m = 0; m < 4; ++m) { const int row = row0 + ai * HALF + m * 16; { const f32x4 a_ = *(const f32x4*)(ssq_cq + (size_t)row * 32), b_ = *(const f32x4*)(ssq_cq + (size_t)row * 32 + 4); rs[ai][m] = rsq((((a_[0] + a_[1]) + (a_[2] + a_[3])) + ((b_[0] + b_[1]) + (b_[2] + b_[3]))) * (1.0f / 512.0f) + EPS); }
                float ss = 0.f;
#pragma unroll
                for (int bj = 0; bj < 2; ++bj)
#pragma unroll
                    for (int n = 0; n < 2; ++n) ss += dot4(acc[ai][bj][m][n]);
                ss = rowsum_fq(ss) * rs[ai][m] * rs[ai][m];
                if (fq == 0) T[(ai * HALF + wr * 64 + m * 16 + fr) * 4 + wc] = ss; }
        asm volatile("s_waitcnt lgkmcnt(0)" ::: "memory"); __builtin_amdgcn_s_barrier(); asm volatile("" ::: "memory");
        if (wc < 2) {
            f32x4 g[2][2];
#pragma unroll
            for (int bj = 0; bj < 2; ++bj)
#pragma unroll
                for (int n = 0; n < 2; ++n) g[bj][n] = *(const f32x4*)(gqn + 64 * wc + 32 * bj + 8 * fq + 4 * n);
#pragma unroll
            for (int ai = 0; ai < 2; ++ai)
#pragma unroll
                for (int m = 0; m < 4; ++m) { const int row = row0 + ai * HALF + m * 16; const f32x4 t = *(const PG8_LAS f32x4*)(T + (ai * HALF + wr * 64 + m * 16 + fr) * 4);
                    const float sc = rsq(((t[0] + t[1]) + (t[2] + t[3])) * (1.0f / 192.0f) + EPS) * QB_SCALE * rs[ai][m];
#pragma unroll
                    for (int bj = 0; bj < 2; ++bj)
                        *(u32x4*)(QB + (size_t)row * QB_PITCH + h * 192 + 64 * wc + 32 * bj + 8 * fq) = pack8(acc[ai][bj][m][0] * sc * g[bj][0], acc[ai][bj][m][1] * sc * g[bj][1]); }
        } else if (wc == 2) {
            f32x4 g1[2], g2[2];
#pragma unroll
            for (int n = 0; n < 2; ++n) { g1[n] = *(const f32x4*)(gqn + 128 + 8 * fq + 4 * n); g2[n] = *(const f32x4*)(gqn + 160 + 8 * fq + 4 * n); }
#pragma unroll
            for (int ai = 0; ai < 2; ++ai)
#pragma unroll
                for (int m = 0; m < 4; ++m) { const int row = row0 + ai * HALF + m * 16; const f32x4 t = *(const PG8_LAS f32x4*)(T + (ai * HALF + wr * 64 + m * 16 + fr) * 4);
                    const float sc = rsq(((t[0] + t[1]) + (t[2] + t[3])) * (1.0f / 192.0f) + EPS) * QB_SCALE * rs[ai][m];
                    f32x4 o1[2], o2[2];
#pragma unroll
                    for (int n = 0; n < 2; ++n) { const f32x4 c = *(const f32x4*)(ropec + (size_t)row * 32 + 8 * fq + 4 * n), s = *(const f32x4*)(ropes + (size_t)row * 32 + 8 * fq + 4 * n);
                        const f32x4 x1 = acc[ai][0][m][n] * sc * g1[n], x2 = acc[ai][1][m][n] * sc * g2[n];
                        o1[n] = x1 * c - x2 * s; o2[n] = x2 * c + x1 * s; }
                    *(u32x4*)(QB + (size_t)row * QB_PITCH + h * 192 + 128 + 8 * fq) = pack8(o1[0], o1[1]);
                    *(u32x4*)(QB + (size_t)row * QB_PITCH + h * 192 + 160 + 8 * fq) = pack8(o2[0], o2[1]); }
        }
    }
};
struct EpiKV {
    static constexpr bool PERM = true, AFTER_DRAIN = false;
    KArg ka; int l; PG8_LAS float* T;
    __device__ __forceinline__ void operator()(const f32x4 (&acc)[2][2][4][2], const Unit& u, int wr, int wc_, int fr_, int fq_) const {
        int fr = fr_, fq = fq_, wc = wc_; asm volatile("" : "+v"(fr), "+v"(fq), "+s"(wc));
        const int row0 = u.pm * BM + wr * 64 + fr, h = u.pn;
        const KArg k = ka_fresh(ka); unsigned char* ws = ka_ptr<unsigned char>(k, KA_WS); const float* ssq_ckv = ka_stats(k, SS_CKV); const float* gkn = ka_ptr<const float>(k, 17) + l * 192;
        bf16_t* KB = (bf16_t*)(ws + WS_KB); bf16_t* VB = (bf16_t*)(ws + WS_VB); const float* SSKR = (const float*)(ws + WS_SSKR); const float* KRR = (const float*)(ws + WS_KRR);
        float rs[2][4];
#pragma unroll
        for (int ai = 0; ai < 2; ++ai)
#pragma unroll
            for (int m = 0; m < 4; ++m) { const int row = row0 + ai * HALF + m * 16; { const f32x4 a_ = *(const f32x4*)(ssq_ckv + (size_t)row * 32); rs[ai][m] = rsq(((a_[0] + a_[1]) + (a_[2] + a_[3])) * (1.0f / 256.0f) + EPS); }
                float ss = dot4(acc[ai][0][m][0]) + dot4(acc[ai][0][m][1]);
                ss = rowsum_fq(ss) * rs[ai][m] * rs[ai][m];
                if (fq == 0) T[(ai * HALF + wr * 64 + m * 16 + fr) * 4 + wc] = ss; }
        asm volatile("s_waitcnt lgkmcnt(0)" ::: "memory"); __builtin_amdgcn_s_barrier(); asm volatile("" ::: "memory");
        f32x4 g[2];
#pragma unroll
        for (int n = 0; n < 2; ++n) g[n] = *(const f32x4*)(gkn + 32 * wc + 8 * fq + 4 * n);
#pragma unroll
        for (int ai = 0; ai < 2; ++ai)
#pragma unroll
            for (int m = 0; m < 4; ++m) { const int row = row0 + ai * HALF + m * 16; const f32x4 t = *(const PG8_LAS f32x4*)(T + (ai * HALF + wr * 64 + m * 16 + fr) * 4);
                const float sh = rsq((((t[0] + t[1]) + (t[2] + t[3])) + SSKR[row]) * (1.0f / 192.0f) + EPS), sc = sh * rs[ai][m];
                *(u32x4*)(KB + (size_t)row * KB_PITCH + h * 192 + 32 * wc + 8 * fq) = pack8(acc[ai][0][m][0] * sc * g[0], acc[ai][0][m][1] * sc * g[1]);
                *(u32x4*)(VB + (size_t)row * VB_PITCH + h * 128 + 32 * wc + 8 * fq) = pack8(acc[ai][1][m][0] * rs[ai][m], acc[ai][1][m][1] * rs[ai][m]);
                const f32x4 kr = *(const f32x4*)(KRR + (size_t)row * 64 + 16 * wc + 4 * fq) * sh;
                u32x2 w; w.x = cvt_pk_bf16(kr[0], kr[1]); w.y = cvt_pk_bf16(kr[2], kr[3]);
                *(u32x2*)(KB + (size_t)row * KB_PITCH + h * 192 + 128 + 16 * wc + 4 * fq) = w; }
    }
};
struct EpiPle {
    static constexpr bool PERM = true, AFTER_DRAIN = false;
    KArg ka; int l;
    __device__ __forceinline__ void operator()(const f32x4 (&acc)[2][2][4][2], const Unit& u, int wr, int wc_, int fr_, int fq_) const {
        int fr = fr_, fq = fq_, wc = wc_; asm volatile("" : "+v"(fr), "+v"(fq), "+s"(wc));
        const int row0 = u.pm * BM + wr * 64 + fr, col0 = u.pn * BM + wc * 32 + 8 * fq;
        const KArg k = ka_fresh(ka); unsigned char* ws = ka_ptr<unsigned char>(k, KA_WS); float* X = ka_ptr<float>(k, KA_OUT); bf16_t* HB = (bf16_t*)(ws + WS_HB2); const bf16_t* PP = (const bf16_t*)(ws + WS_PP);
        const float* ssq_h = ka_stats(k, SS_3); const float* ssq_pp = ka_stats(k, SS_PP); const float* gpp = ka_ptr<const float>(k, 26) + l * DM; float* ssq_out = ka_stats(k, SS_IN);
        f32x4 g[2][2];
#pragma unroll
        for (int bj = 0; bj < 2; ++bj)
#pragma unroll
            for (int n = 0; n < 2; ++n) g[bj][n] = *(const f32x4*)(gpp + col0 + bj * HALF + 4 * n);
#pragma unroll
        for (int ai = 0; ai < 2; ++ai)
#pragma unroll
            for (int m = 0; m < 4; ++m) { const int row = row0 + ai * HALF + m * 16; const float rs = rsq(ssq32(ssq_h, row, fq) * (1.0f / DM) + EPS), rp = rsq(ssq32(ssq_pp, row, fq) * (1.0f / DM) + EPS);
                float part = 0.f;
#pragma unroll
                for (int bj = 0; bj < 2; ++bj) { float* xp = X + (size_t)row * DM + col0 + bj * HALF;
                    f32x4 x0 = *(const f32x4*)xp, x1 = *(const f32x4*)(xp + 4);
                    const u32x4 pw = *(const u32x4*)(PP + (size_t)row * DM + col0 + bj * HALF);
                    const f32x4 p0 = (f32x4){bf_lo(pw.x), bf_hi(pw.x), bf_lo(pw.y), bf_hi(pw.y)}, p1 = (f32x4){bf_lo(pw.z), bf_hi(pw.z), bf_lo(pw.w), bf_hi(pw.w)};
                    const f32x4 a0 = acc[ai][bj][m][0] * rs, a1 = acc[ai][bj][m][1] * rs;
                    const f32x4 s0 = (f32x4){sigm1(a0[0]), sigm1(a0[1]), sigm1(a0[2]), sigm1(a0[3])}, s1 = (f32x4){sigm1(a1[0]), sigm1(a1[1]), sigm1(a1[2]), sigm1(a1[3])};
                    x0 = x0 + p0 * rp * g[bj][0] * s0; x1 = x1 + p1 * rp * g[bj][1] * s1;
                    *(f32x4*)xp = x0; *(f32x4*)(xp + 4) = x1;
                    *(u32x4*)(HB + (size_t)row * DM + col0 + bj * HALF) = pack8(x0, x1);
                    part += dot4(x0) + dot4(x1); }
                part = rowsum_fq(part);
                if (fq == 0) ssq_out[(size_t)row * 32 + u.pn * 4 + wc] = part; }
    }
};
}
namespace att {
typedef short bf16x8 __attribute__((ext_vector_type(8)));
typedef short s16x4 __attribute__((ext_vector_type(4)));
typedef float f32x16 __attribute__((ext_vector_type(16)));
typedef float f32x4 __attribute__((ext_vector_type(4)));
typedef unsigned u32x4 __attribute__((ext_vector_type(4)));
typedef int i32x4 __attribute__((ext_vector_type(4)));
typedef __attribute__((address_space(3))) char* lptr;
#define ATT_LAS __attribute__((address_space(3)))
#define ATT_SBAR() __builtin_amdgcn_sched_barrier(0)
constexpr int KROW_MLA = 400, KT_MLA = 64 * KROW_MLA, VT_MLA = 64 * 128 * 2;
constexpr int KROW_SWA = 144, KT_SWA = 64 * KROW_SWA, VT_SWA = 64 * 64 * 2;
constexpr int MLA_K = 0, MLA_V = 2 * KT_MLA;
constexpr int SWA_K = 0, SWA_V = 4 * KT_SWA, SWA_POS = SWA_V + 4 * VT_SWA;
constexpr int LDS_SCR = 90112;
constexpr int ATT_LDS_BYTES = LDS_SCR + 8 * 64 * 4;

__device__ __forceinline__ int crow(int r, int hi) { return (r & 3) + 8 * (r >> 2) + 4 * hi; }
__device__ __forceinline__ unsigned cvtpk(float lo, float hi) { unsigned r; asm volatile("v_cvt_pk_bf16_f32 %0, %1, %2" : "=v"(r) : "v"(lo), "v"(hi)); return r; }
template <int NCB> __device__ __forceinline__ int v_st(int k, int c) { const int kk = (k & ~0xC) | ((k & 4) << 1) | ((k & 8) >> 1); return ((kk >> 3) * NCB + (c >> 5)) * 512 + ((kk & 7) * 32 + (c & 31)) * 2; }
__device__ __forceinline__ int v_rd_base(int lane) { return ((lane & 3) << 3) | (((lane >> 2) & 3) << 6) | (((lane >> 4) & 1) << 5) | (((lane >> 5) & 1) << 8); }

__device__ __forceinline__ void mask_tile(f32x16& p0, f32x16& p1, int dq, unsigned W) {
    const float NEG = -__builtin_inff();
#pragma unroll
    for (int r = 0; r < 16; ++r) { const int c = (r & 3) + 8 * (r >> 2);
        if ((unsigned)(dq - c) >= W) p0[r] = NEG;
        if ((unsigned)(dq - c - 32) >= W) p1[r] = NEG; }
}
template <int ND0, int KROW> __device__ __forceinline__ void qkt(f32x16& p0, f32x16& p1, lptr kt, int r32, int hi, const bf16x8* qr) {
    p0 = f32x16{}; p1 = f32x16{};
    const lptr a = kt + r32 * KROW + hi * 16;
#pragma unroll
    for (int d0 = 0; d0 < ND0; ++d0) {
        const bf16x8 b0 = *(const ATT_LAS bf16x8*)(a + d0 * 32);
        const bf16x8 b1 = *(const ATT_LAS bf16x8*)(a + 32 * KROW + d0 * 32);
        p0 = __builtin_amdgcn_mfma_f32_32x32x16_bf16(b0, qr[d0], p0, 0, 0, 0);
        p1 = __builtin_amdgcn_mfma_f32_32x32x16_bf16(b1, qr[d0], p1, 0, 0, 0); }
}
__device__ __forceinline__ void softmax_tile(f32x16& p0, f32x16& p1, float& m_reg, float& l_reg, float& alpha, bf16x8& pa0, bf16x8& pa1, bf16x8& pa2, bf16x8& pa3) {
    float pmax = p0[0];
#pragma unroll
    for (int r = 1; r < 16; ++r) pmax = fmaxf(pmax, p0[r]);
#pragma unroll
    for (int r = 0; r < 16; ++r) pmax = fmaxf(pmax, p1[r]);
    { auto rr = __builtin_amdgcn_permlane32_swap(__float_as_uint(pmax), __float_as_uint(pmax), false, false); pmax = fmaxf(__uint_as_float(rr[0]), __uint_as_float(rr[1])); }
    const float mn = fmaxf(m_reg, pmax); alpha = __builtin_amdgcn_exp2f(m_reg - mn); m_reg = mn;
    float ps = 0.f;
#pragma unroll
    for (int r = 0; r < 16; ++r) { p0[r] = __builtin_amdgcn_exp2f(p0[r] - mn); ps += p0[r]; }
#pragma unroll
    for (int r = 0; r < 16; ++r) { p1[r] = __builtin_amdgcn_exp2f(p1[r] - mn); ps += p1[r]; }
    { auto rr = __builtin_amdgcn_permlane32_swap(__float_as_uint(ps), __float_as_uint(ps), false, false); ps = __uint_as_float(rr[0]) + __uint_as_float(rr[1]); }
    l_reg = l_reg * alpha + ps;
#define ATT_PK4(P, B_, OUT) do { unsigned a0 = cvtpk(P[B_+0], P[B_+1]), a1 = cvtpk(P[B_+2], P[B_+3]); unsigned b0 = cvtpk(P[B_+4], P[B_+5]), b1 = cvtpk(P[B_+6], P[B_+7]); \
        auto r0 = __builtin_amdgcn_permlane32_swap(a0, b0, false, false); auto r1 = __builtin_amdgcn_permlane32_swap(a1, b1, false, false); \
        u32x4 w = {r0[0], r1[0], r0[1], r1[1]}; OUT = __builtin_bit_cast(bf16x8, w); } while (0)
    ATT_PK4(p0, 0, pa0); ATT_PK4(p0, 8, pa1); ATT_PK4(p1, 0, pa2); ATT_PK4(p1, 8, pa3);
#undef ATT_PK4
}
#define ATT_TRRD(dst, off) asm volatile("ds_read_b64_tr_b16 %0, %1 offset:%2" : "=&v"(dst) : "v"(vb), "i"(off) : "memory")
#define ATT_PV_D0(NCB, d0) do { s16x4 l0, l1, l2, l3, h0, h1, h2, h3; constexpr int b_ = (d0) * 512, ks_ = (NCB) * 1024, hf_ = (NCB) * 512; \
        ATT_TRRD(l0, b_); ATT_TRRD(h0, b_ + hf_); ATT_TRRD(l1, b_ + ks_); ATT_TRRD(h1, b_ + ks_ + hf_); ATT_TRRD(l2, b_ + 2 * ks_); ATT_TRRD(h2, b_ + 2 * ks_ + hf_); ATT_TRRD(l3, b_ + 3 * ks_); ATT_TRRD(h3, b_ + 3 * ks_ + hf_); \
        asm volatile("s_waitcnt lgkmcnt(0)" ::: "memory"); ATT_SBAR(); \
        o[d0] = __builtin_amdgcn_mfma_f32_32x32x16_bf16(pa0, (bf16x8){l0[0], l0[1], l0[2], l0[3], h0[0], h0[1], h0[2], h0[3]}, o[d0], 0, 0, 0); \
        o[d0] = __builtin_amdgcn_mfma_f32_32x32x16_bf16(pa1, (bf16x8){l1[0], l1[1], l1[2], l1[3], h1[0], h1[1], h1[2], h1[3]}, o[d0], 0, 0, 0); \
        o[d0] = __builtin_amdgcn_mfma_f32_32x32x16_bf16(pa2, (bf16x8){l2[0], l2[1], l2[2], l2[3], h2[0], h2[1], h2[2], h2[3]}, o[d0], 0, 0, 0); \
        o[d0] = __builtin_amdgcn_mfma_f32_32x32x16_bf16(pa3, (bf16x8){l3[0], l3[1], l3[2], l3[3], h3[0], h3[1], h3[2], h3[3]}, o[d0], 0, 0, 0); } while (0)
__device__ __forceinline__ void pv4(f32x16* o, int vb, bf16x8 pa0, bf16x8 pa1, bf16x8 pa2, bf16x8 pa3) { ATT_PV_D0(4, 0); ATT_PV_D0(4, 1); ATT_PV_D0(4, 2); ATT_PV_D0(4, 3); }
__device__ __forceinline__ void pv2(f32x16* o, int vb, bf16x8 pa0, bf16x8 pa1, bf16x8 pa2, bf16x8 pa3) { ATT_PV_D0(2, 0); ATT_PV_D0(2, 1); }
#define ATT_RESC(ND, a) do { if (__any((a) < 1.f)) { if (hi == 0) al_l[r32] = (a); asm volatile("s_waitcnt lgkmcnt(0)" ::: "memory"); \
        _Pragma("unroll") for (int d_ = 0; d_ < ND; ++d_) _Pragma("unroll") for (int r = 0; r < 16; ++r) o[d_][r] *= al_l[crow(r, hi)]; } } while (0)

__device__ __forceinline__ void mla_unit(int b, int h, int qb, const short* __restrict__ QBp, const short* __restrict__ KBp, const short* __restrict__ VBp, short* Op, lptr lds) {
    int tid_ = threadIdx.x; asm volatile("" : "+v"(tid_));
    const int tid = tid_, wid = __builtin_amdgcn_readfirstlane(tid >> 6), lane = tid & 63, r32 = lane & 31, hi = lane >> 5;
    const size_t rowbase = (size_t)b * SEQ; const int q0 = qb * 256;
    bf16x8 qr[12];
    { const short* qp = QBp + (rowbase + q0 + wid * 32 + r32) * QB_PITCH + h * 192 + hi * 8;
#pragma unroll
      for (int d0 = 0; d0 < 12; ++d0) qr[d0] = *(const bf16x8*)(qp + d0 * 16); }
    const short* Kg = KBp + rowbase * KB_PITCH + h * 192; const short* Vg = VBp + rowbase * VB_PITCH + h * 128;
    const int NT = 4 * (qb + 1);
    int kgo[3], klo[3], vgo[2], vlo[2];
#pragma unroll
    for (int i = 0; i < 3; ++i) { const int c = tid + 512 * i, row = c / 24, ch = c % 24; kgo[i] = row * KB_PITCH + ch * 8; klo[i] = row * KROW_MLA + ch * 16; }
#pragma unroll
    for (int i = 0; i < 2; ++i) { const int c = tid + 512 * i, row = c >> 4, ch = c & 15; vgo[i] = row * VB_PITCH + ch * 8; vlo[i] = v_st<4>(row, ch * 8); }
    bf16x8 sk[3], sv[2];
#define MLA_LOADT(t) do { const short* kp_ = Kg + (size_t)(t) * 64 * KB_PITCH; const short* vp_ = Vg + (size_t)(t) * 64 * VB_PITCH; \
        _Pragma("unroll") for (int i = 0; i < 3; ++i) sk[i] = *(const bf16x8*)(kp_ + kgo[i]); _Pragma("unroll") for (int i = 0; i < 2; ++i) sv[i] = *(const bf16x8*)(vp_ + vgo[i]); } while (0)
#define MLA_WRITET(bf) do { _Pragma("unroll") for (int i = 0; i < 3; ++i) *(ATT_LAS bf16x8*)(lds + MLA_K + (bf) * KT_MLA + klo[i]) = sk[i]; \
        _Pragma("unroll") for (int i = 0; i < 2; ++i) *(ATT_LAS bf16x8*)(lds + MLA_V + (bf) * VT_MLA + vlo[i]) = sv[i]; } while (0)
    MLA_LOADT(0); MLA_WRITET(0); __syncthreads();
    float m_reg = -1e30f, l_reg = 0.f; f32x16 o[4] = {};
    ATT_LAS float* al_l = (ATT_LAS float*)(lds + LDS_SCR) + wid * 64; ATT_LAS float* li_l = al_l + 32;
    const int vb0 = (int)(unsigned)(size_t)(lds + MLA_V) + v_rd_base(lane);
    const int qlo = q0 + wid * 32, qpos = qlo + r32;
    for (int t = 0; t < NT; ++t) {
        const int bf = t & 1;
        if (t + 1 < NT) MLA_LOADT(t + 1);
        f32x16 p0, p1; qkt<12, KROW_MLA>(p0, p1, lds + MLA_K + bf * KT_MLA, r32, hi, qr);
        const int kb_ = t * 64;
        if (kb_ + 63 > qlo) mask_tile(p0, p1, qpos - kb_ - 4 * hi, 0x7fffffffu);
        float alpha; bf16x8 pa0, pa1, pa2, pa3;
        softmax_tile(p0, p1, m_reg, l_reg, alpha, pa0, pa1, pa2, pa3);
        ATT_RESC(4, alpha);
        pv4(o, vb0 + bf * VT_MLA, pa0, pa1, pa2, pa3);
        if (t + 1 < NT) MLA_WRITET(bf ^ 1);
        __syncthreads();
    }
#undef MLA_LOADT
#undef MLA_WRITET
    if (hi == 0) li_l[r32] = l_reg; asm volatile("s_waitcnt lgkmcnt(0)" ::: "memory");
    float rli[16];
#pragma unroll
    for (int r = 0; r < 16; ++r) rli[r] = __builtin_amdgcn_rcpf(li_l[crow(r, hi)]);
    short* Ow = Op + (rowbase + q0 + wid * 32) * 2048 + 1024 + h * 128;
#pragma unroll
    for (int r = 0; r < 16; ++r) { const int orow = crow(r, hi);
#pragma unroll
        for (int d0 = 0; d0 < 4; ++d0) { const float v = o[d0][r] * rli[r]; const float vn = __shfl_xor(v, 1);
            if ((r32 & 1) == 0) *(unsigned*)(Ow + (size_t)orow * 2048 + d0 * 32 + r32) = cvtpk(v, vn); } }
}
__device__ __forceinline__ void swa_unit(int b, int kvh, int n, const short* __restrict__ QAp, const short* __restrict__ KAp, const short* __restrict__ VAp, const int* __restrict__ pos, const float* __restrict__ sinks, short* Op, lptr lds) {
    int tid_ = threadIdx.x; asm volatile("" : "+v"(tid_));
    const int tid = tid_, wid = __builtin_amdgcn_readfirstlane(tid >> 6), lane = tid & 63, r32 = lane & 31, hi = lane >> 5;
    const size_t rowbase = (size_t)b * SEQ; const int key0 = 128 * (n - 1);
    ATT_LAS int* posl = (ATT_LAS int*)(lds + SWA_POS);
#pragma unroll
    for (int i = 0; i < 4; ++i) { const int c = tid + 512 * i, row = c >> 3, ch = c & 7;
        if (key0 + row >= 0) {
            const bf16x8 kk = *(const bf16x8*)(KAp + (rowbase + key0 + row) * KA_PITCH + kvh * 64 + ch * 8);
            const bf16x8 vv = *(const bf16x8*)(VAp + (rowbase + key0 + row) * VA_PITCH + kvh * 64 + ch * 8);
            *(ATT_LAS bf16x8*)(lds + SWA_K + row * KROW_SWA + ch * 16) = kk;
            *(ATT_LAS bf16x8*)(lds + SWA_V + (row >> 6) * VT_SWA + v_st<2>(row & 63, ch * 8)) = vv; } }
    if (tid < 256 && key0 + tid >= 0) posl[tid] = pos[rowbase + key0 + tid];
    __syncthreads();
    ATT_LAS float* al_l = (ATT_LAS float*)(lds + LDS_SCR) + wid * 64; ATT_LAS float* li_l = al_l + 32;
    const int vb0 = (int)(unsigned)(size_t)(lds + SWA_V) + v_rd_base(lane);
    for (int tk = 0; tk < 2; ++tk) {
        const int task = wid + 8 * tk, g = task >> 2, rho = task & 3, hq = 4 * kvh + g, qrow0 = 128 * n + 32 * rho;
        bf16x8 qr[4];
        { const short* qp = QAp + (rowbase + qrow0 + r32) * QA_PITCH + hq * 64 + hi * 8;
#pragma unroll
          for (int d0 = 0; d0 < 4; ++d0) qr[d0] = *(const bf16x8*)(qp + d0 * 16); }
        const int pq = pos[rowbase + qrow0 + r32];
        const float slope2 = __builtin_amdgcn_exp2f(-0.5f * (float)(hq + 1)) * LOG2E;
        float m_reg = sinks[hq] * LOG2E, l_reg = 1.0f; f32x16 o[2] = {};
        for (int j = 0; j < 3; ++j) { const int lt = (rho >> 1) + j;
            if (n == 0 && lt < 2) continue;
            f32x16 p0, p1; qkt<4, KROW_SWA>(p0, p1, lds + SWA_K + lt * KT_SWA, r32, hi, qr);
#pragma unroll
            for (int g4 = 0; g4 < 4; ++g4) { const i32x4 k0 = *(const ATT_LAS i32x4*)(posl + lt * 64 + 8 * g4 + 4 * hi), k1 = *(const ATT_LAS i32x4*)(posl + lt * 64 + 32 + 8 * g4 + 4 * hi);
#pragma unroll
                for (int e = 0; e < 4; ++e) { int d0_ = pq - k0[e], d1_ = pq - k1[e]; d0_ = d0_ < 0 ? -d0_ : d0_; d1_ = d1_ < 0 ? -d1_ : d1_;
                    p0[4 * g4 + e] -= slope2 * (float)d0_; p1[4 * g4 + e] -= slope2 * (float)d1_; } }
            mask_tile(p0, p1, (qrow0 + r32) - (key0 + 64 * lt) - 4 * hi, 128u);
            float alpha; bf16x8 pa0, pa1, pa2, pa3;
            softmax_tile(p0, p1, m_reg, l_reg, alpha, pa0, pa1, pa2, pa3);
            ATT_RESC(2, alpha);
            pv2(o, vb0 + lt * VT_SWA, pa0, pa1, pa2, pa3);
        }
        if (hi == 0) li_l[r32] = l_reg; asm volatile("s_waitcnt lgkmcnt(0)" ::: "memory");
        float rli[16];
#pragma unroll
        for (int r = 0; r < 16; ++r) rli[r] = __builtin_amdgcn_rcpf(li_l[crow(r, hi)]);
        short* Ow = Op + (rowbase + qrow0) * 2048 + hq * 64;
#pragma unroll
        for (int r = 0; r < 16; ++r) { const int orow = crow(r, hi);
#pragma unroll
            for (int d0 = 0; d0 < 2; ++d0) { const float v = o[d0][r] * rli[r]; const float vn = __shfl_xor(v, 1);
                if ((r32 & 1) == 0) *(unsigned*)(Ow + (size_t)orow * 2048 + d0 * 32 + r32) = cvtpk(v, vn); } }
    }
    __syncthreads();
}
#undef ATT_RESC
}
constexpr int NWAVES = 8;
constexpr int CW_BAR = 4096;
constexpr int RING_BYTES = 131072, EPI_T_OFF = RING_BYTES, MISC_OFF = RING_BYTES + 4096, LDS_BYTES = 147456;
static_assert(att::ATT_LDS_BYTES <= RING_BYTES, "attention scratch fits the ring region");

#define GAS __attribute__((address_space(1)))
#define LAS __attribute__((address_space(3)))
typedef unsigned short bf16;
typedef unsigned v4u __attribute__((ext_vector_type(4)));
typedef float f32x4 __attribute__((ext_vector_type(4)));
typedef short bf16x8 __attribute__((ext_vector_type(8)));
typedef GAS unsigned gu32;
typedef GAS unsigned long long gu64;
#define RLX_AGENT __ATOMIC_RELAXED, __HIP_MEMORY_SCOPE_AGENT
#define LDS_WAIT() asm volatile("s_waitcnt lgkmcnt(0)" ::: "memory")
#define VM_WAIT() asm volatile("s_waitcnt vmcnt(0)" ::: "memory")
__device__ __forceinline__ unsigned long long rt() { return __builtin_amdgcn_s_memrealtime(); }
__device__ __forceinline__ unsigned f2bf(float f) { unsigned u = __builtin_bit_cast(unsigned, f); return (u + 0x7fffu + ((u >> 16) & 1u)) >> 16; }
__device__ __forceinline__ unsigned pk2(float lo, float hi) { return f2bf(lo) | (f2bf(hi) << 16); }

#define XB_TMO      128
#define XB_XCNT(j)  (256  + 64 * (j))
#define XB_XSUB(j)  (1280 + 64 * (j))
#define XB_XGEN(j)  (2304 + 64 * (j))
#define XB_TOP      3328
#define XB_TOPGEN   3392
#define XCD_BAR_WORDS 3456
#define XB_SPIN_CAP (1u << 18)

__device__ __forceinline__ unsigned xb_ld(unsigned* p)              { return __hip_atomic_load(p, __ATOMIC_RELAXED, __HIP_MEMORY_SCOPE_AGENT); }
__device__ __forceinline__ unsigned xb_add(unsigned* p, unsigned v) { return __hip_atomic_fetch_add(p, v, __ATOMIC_RELAXED, __HIP_MEMORY_SCOPE_AGENT); }
__device__ __forceinline__ unsigned xb_xcc_id() { return (unsigned)__builtin_amdgcn_s_getreg((3 << 11) | 20) & 0xFu; }
#define XB_SPIN(cond, bar) do { unsigned _sp = 0; while (cond) { __builtin_amdgcn_s_sleep(1); \
    if ((++_sp & 255u) == 0u) { if (xb_ld(&(bar)[XB_TMO])) break; if (_sp > XB_SPIN_CAP) { atomicAdd(&(bar)[XB_TMO], 1u); break; } } } } while (0)

struct XcdBarrier {
    unsigned* bar; unsigned x;
    volatile LAS unsigned* st;
};

__device__ __forceinline__ XcdBarrier xcd_barrier_post(unsigned* bar, volatile LAS unsigned* st) {
    XcdBarrier b; b.bar = bar; b.x = xb_xcc_id(); b.st = st;
    if (threadIdx.x == 0) (void)xb_add(&bar[XB_XCNT(b.x)], 1u);
    return b;
}
__device__ __forceinline__ void xcd_barrier_complete(unsigned* bar, unsigned x, unsigned& nloc, unsigned& nx) {
    const unsigned G = gridDim.x * gridDim.y * gridDim.z;
    unsigned sum, cnt, mine, sp = 0u;
    for (;;) {
        sum = 0u; cnt = 0u; mine = 0u;
#pragma unroll
        for (unsigned j = 0; j < 16; ++j) { const unsigned c = xb_ld(&bar[XB_XCNT(j)]); sum += c; cnt += (c > 0u) ? 1u : 0u; mine = (j == x) ? c : mine; }
        if (sum == G) break;
        __builtin_amdgcn_s_sleep(1);
        if ((++sp & 255u) == 0u) { if (xb_ld(&bar[XB_TMO])) break; if (sp > XB_SPIN_CAP) { atomicAdd(&bar[XB_TMO], 1u); break; } }
    }
    nloc = mine > 0u ? mine : 1u; nx = cnt > 0u ? cnt : 1u;
}

__device__ __forceinline__ void xcd_barrier(const XcdBarrier& b) {
    asm volatile("s_waitcnt vmcnt(0)" ::: "memory");
    __syncthreads();
    if (threadIdx.x == 0) {
        unsigned* bar = b.bar; unsigned bxcc = b.x; asm volatile("" : "+s"(bar), "+s"(bxcc));
        __builtin_amdgcn_s_waitcnt(0);
        unsigned nloc = b.st[0], nx = b.st[1];
        if (nloc == 0u) { xcd_barrier_complete(bar, bxcc, nloc, nx); b.st[0] = nloc; b.st[1] = nx; }
        const unsigned old = xb_add(&bar[XB_XSUB(bxcc)], 1u);
        const unsigned gen = old / nloc;
        if (old + 1u == (gen + 1u) * nloc) {
            __builtin_amdgcn_fence(__ATOMIC_RELEASE, "agent");
            asm volatile("s_waitcnt vmcnt(0)" ::: "memory");
            const unsigned og = xb_add(&bar[XB_TOP], 1u);
            const unsigned tg = og / nx;
            if (og + 1u == (tg + 1u) * nx) xb_add(&bar[XB_TOPGEN], 1u);
            else XB_SPIN(xb_ld(&bar[XB_TOPGEN]) == tg, bar);
            __builtin_amdgcn_fence(__ATOMIC_ACQUIRE, "agent");
            xb_add(&bar[XB_XGEN(bxcc)], 1u);
            asm volatile("s_waitcnt vmcnt(0)" ::: "memory");
        } else {
            XB_SPIN(xb_ld(&bar[XB_XGEN(bxcc)]) == gen, bar);
            __builtin_amdgcn_fence(__ATOMIC_ACQUIRE, "agent");
            asm volatile("s_waitcnt vmcnt(0)" ::: "memory");
        }
    }
    __syncthreads();
}

__device__ __forceinline__ void cvt_item(const float* __restrict__ W, int ldw, int c0, int k0, const float* __restrict__ gain, bf16* dst, int K, int n0, LAS float* scr, int lane) {
    const int c = lane & 7;
    if (c0 < 0) {
#pragma unroll
        for (int j = 0; j < 4; ++j) { const int n = (lane >> 3) + 8 * j; *(v4u*)(dst + (size_t)(n0 + n) * K + k0 + 8 * c) = (v4u){0u, 0u, 0u, 0u}; }
        return;
    }
#pragma unroll
    for (int i = 0; i < 8; ++i) { const int kk = 8 * i + (lane >> 3);
        f32x4 v = *(const f32x4*)(W + (size_t)(k0 + kk) * ldw + c0 + 4 * c);
        if (gain) v = v * gain[k0 + kk];
        LAS float* s = scr + kk * 33 + 4 * c; s[0] = v[0]; s[1] = v[1]; s[2] = v[2]; s[3] = v[3]; }
    LDS_WAIT(); asm volatile("" ::: "memory");
#pragma unroll
    for (int j = 0; j < 4; ++j) { const int n = (lane >> 3) + 8 * j; const LAS float* s = scr + (8 * c) * 33 + n;
        v4u o; o.x = pk2(s[0 * 33], s[1 * 33]); o.y = pk2(s[2 * 33], s[3 * 33]); o.z = pk2(s[4 * 33], s[5 * 33]); o.w = pk2(s[6 * 33], s[7 * 33]);
        *(v4u*)(dst + (size_t)(n0 + n) * K + k0 + 8 * c) = o; }
    LDS_WAIT(); asm volatile("" ::: "memory");
}
__device__ __forceinline__ float wave_sum(float v) {
#pragma unroll
    for (int o = 1; o < 64; o <<= 1) v += __shfl_xor(v, o);
    return v;
}

__device__ __forceinline__ int opaque_i(int v) { asm volatile("" : "+s"(v)); return v; }
struct Args { const void* in[29]; float* out; unsigned char* ws; };

__device__ __forceinline__ int win_src_col(int g32) {
    const int tile = g32 >> 3, bj = (g32 >> 2) & 1, wc = g32 & 3;
    if (tile < 4) return (4 * tile + wc) * 64 + 32 * bj;
    if (tile == 4) return 1024 + wc * 64 + 32 * bj;
    if (tile < 9) return 1280 + (tile - 5) * 256 + (g32 & 7) * 32;
    return wc == 0 ? 2304 + 32 * bj : -1;
}

__global__ void __launch_bounds__(NWAVES * 64, 2) hybrid_fwd(Args args) {
    extern __shared__ __attribute__((aligned(16))) unsigned char lds_raw[];
    LAS unsigned char* lds = (LAS unsigned char*)lds_raw;
    volatile LAS unsigned* MISC = (volatile LAS unsigned*)(lds + MISC_OFF);
    const int tid = threadIdx.x, lane = tid & 63, wave = __builtin_amdgcn_readfirstlane(tid >> 6);
    const int G = gridDim.x, bx = blockIdx.x, vcu = (G % 8 == 0) ? (bx % 8) * (G / 8) + bx / 8 : bx;
    const KArg ka0 = (KArg)__builtin_amdgcn_kernarg_segment_ptr();
    for (int u = tid; u < (LDS_BYTES - MISC_OFF) / 4; u += NWAVES * 64) ((LAS unsigned*)(lds + MISC_OFF))[u] = 0u;
    __syncthreads();
    XcdBarrier bar = xcd_barrier_post((unsigned*)(ka_ptr<unsigned char>(ka0, KA_WS) + WS_CTL) + CW_BAR, MISC + 8);
#define GRID_BAR() xcd_barrier(bar)
#define KIN(k, i) ((const float*)ka_ptr<const void>(k, i))
    const int gw = vcu * NWAVES + wave, NGW = G * NWAVES;

#ifndef DBG_NO_P0
    {
        const KArg k = ka_fresh(ka0); unsigned char* ws = ka_ptr<unsigned char>(k, KA_WS);
        LAS float* scr = (LAS float*)(lds + wave * 16384);
        constexpr int I_GU = (11264 / 32) * (2048 / 64), I_D = (2048 / 32) * (5632 / 64), I_IN = (NIN / 32) * (2048 / 64), I_UQ = (2048 / 32) * (512 / 64), I_UKV = (2048 / 32) * (256 / 64),
                      I_O = (2048 / 32) * (2048 / 64), I_PG = I_O, I_PP = (2048 / 32) * (256 / 64);
        constexpr int I_LAYER = 2 * I_GU + 2 * I_D + I_IN + I_UQ + I_UKV + I_O + I_PG + I_PP;
        for (int it = gw; it < DEPTH * I_LAYER; it += NGW) {
            const int l = it / I_LAYER; int r = it % I_LAYER;
            unsigned char* wl = ws + WS_W + (size_t)l * W_LAYER;
            if (r < 2 * I_GU) {
                const int f = r / I_GU; r -= f * I_GU; const int g32 = r / 32, kb = r % 32, tile = g32 >> 3, bj = (g32 >> 2) & 1, q = g32 & 3;
                const float* src = KIN(k, f ? (bj ? 23 : 22) : (bj ? 5 : 4)) + (size_t)l * DM * DFF;
                const float* gain = KIN(k, f ? 21 : 3) + l * DM;
                cvt_item(src, DFF, tile * 128 + q * 32, kb * 64, gain, (bf16*)(wl + (f ? W_2GU : W_1GU)), DM, g32 * 32, scr, lane); continue; }
            r -= 2 * I_GU;
            if (r < 2 * I_D) {
                const int f = r / I_D; r -= f * I_D; const int g32 = r / 88, kb = r % 88;
                const float* src = KIN(k, f ? 24 : 6) + (size_t)l * DFF * DM;
                cvt_item(src, DM, g32 * 32, kb * 64, nullptr, (bf16*)(wl + (f ? W_2D : W_1D)), DFF, g32 * 32, scr, lane); continue; }
            r -= 2 * I_D;
            if (r < I_IN) { const int g32 = r / 32, kb = r % 32;
                cvt_item(KIN(k, 8) + (size_t)l * DM * 2368, 2368, win_src_col(g32), kb * 64, KIN(k, 7) + l * DM, (bf16*)(wl + W_IN), DM, g32 * 32, scr, lane); continue; }
            r -= I_IN;
            if (r < I_UQ) { const int g32 = r / 8, kb = r % 8, h = g32 >> 3, bj = (g32 >> 2) & 1, wc = g32 & 3;
                cvt_item(KIN(k, 13) + (size_t)l * 512 * 1536, 1536, wc < 3 ? h * 192 + 64 * wc + 32 * bj : -1, kb * 64, KIN(k, 12) + l * 512, (bf16*)(wl + W_UQ), 512, g32 * 32, scr, lane); continue; }
            r -= I_UQ;
            if (r < I_UKV) { const int g32 = r / 4, kb = r % 4;
                cvt_item(KIN(k, 15) + (size_t)l * 256 * 2048, 2048, g32 * 32, kb * 64, KIN(k, 14) + l * 256, (bf16*)(wl + W_UKV), 256, g32 * 32, scr, lane); continue; }
            r -= I_UKV;
            if (r < I_O) { const int g32 = r / 32, kb = r % 32;
                const float* gain = kb < 16 ? KIN(k, 18) + l * 1024 : KIN(k, 19) + l * 1024 - 1024;
                cvt_item(KIN(k, 20) + (size_t)l * DM * DM, DM, g32 * 32, kb * 64, gain, (bf16*)(wl + W_O), DM, g32 * 32, scr, lane); continue; }
            r -= I_O;
            if (r < I_PG) { const int g32 = r / 32, kb = r % 32;
                cvt_item(KIN(k, 28) + (size_t)l * DM * DM, DM, g32 * 32, kb * 64, KIN(k, 27) + l * DM, (bf16*)(wl + W_PG), DM, g32 * 32, scr, lane); continue; }
            r -= I_PG;
            { const int g32 = r / 4, kb = r % 4;
                cvt_item(KIN(k, 25) + (size_t)l * PLE * DM, DM, g32 * 32, kb * 64, nullptr, (bf16*)(wl + W_PP), PLE, g32 * 32, scr, lane); }
        }
        { const float* xin = KIN(k, 0); float* ss0 = ka_stats(k, SS_IN); float* X = ka_ptr<float>(k, KA_OUT); bf16* HB = (bf16*)(ws + WS_HB2);
          for (int m = gw; m < MROWS; m += NGW) { float s = 0.f;
#pragma unroll
              for (int j = 0; j < 4; ++j) { const int col = j * 512 + lane * 8; const f32x4 a = *(const f32x4*)(xin + (size_t)m * DM + col), b2 = *(const f32x4*)(xin + (size_t)m * DM + col + 4);
                  *(f32x4*)(X + (size_t)m * DM + col) = a; *(f32x4*)(X + (size_t)m * DM + col + 4) = b2;
                  v4u o; o.x = pk2(a[0], a[1]); o.y = pk2(a[2], a[3]); o.z = pk2(b2[0], b2[1]); o.w = pk2(b2[2], b2[3]); *(v4u*)(HB + (size_t)m * DM + col) = o;
                  s += (a[0] * a[0] + a[1] * a[1]) + (a[2] * a[2] + a[3] * a[3]) + (b2[0] * b2[0] + b2[1] * b2[1]) + (b2[2] * b2[2] + b2[3] * b2[3]); }
              s = wave_sum(s); if (lane < 32) ss0[(size_t)m * 32 + lane] = lane == 0 ? s : 0.f; } }
        { const float* pin = KIN(k, 1); bf16* PB = (bf16*)(ws + WS_PB); const size_t n8 = (size_t)DEPTH * MROWS * PLE / 8;
          for (size_t i = (size_t)bx * 512 + tid; i < n8; i += (size_t)G * 512) { const f32x4 a = *(const f32x4*)(pin + i * 8), b2 = *(const f32x4*)(pin + i * 8 + 4);
              v4u o; o.x = pk2(a[0], a[1]); o.y = pk2(a[2], a[3]); o.z = pk2(b2[0], b2[1]); o.w = pk2(b2[2], b2[3]); *(v4u*)(PB + i * 8) = o; } }
        { const int* positions = ka_ptr<const int>(k, 2); float* ROPEC = (float*)(ws + WS_ROPEC); float* ROPES = (float*)(ws + WS_ROPES);
          for (int i = bx * 512 + tid; i < MROWS * 32; i += G * 512) { const int m = i >> 5, kk = i & 31;
            const float inv = powf(10000.0f, -(float)kk / 32.0f), ang = (float)positions[m] * inv;
            ROPEC[i] = cosf(ang); ROPES[i] = sinf(ang); } }
    }
#endif
    GRID_BAR();

    LAS float* epiT = (LAS float*)(lds + EPI_T_OFF);
    for (int hl = 0; hl < 2 * DEPTH; ++hl) {
        const int l = hl >> 1, second = hl & 1;
        { const KArg k = ka_fresh(ka0); unsigned char* ws = ka_ptr<unsigned char>(k, KA_WS);
          pg8::Gemm g{(const bf16*)(ws + (second ? WS_HB : WS_HB2)), (const bf16*)(ws + WS_W + (size_t)l * W_LAYER + (second ? W_2GU : W_1GU)), MROWS, 11264, DM}; pg8::StaticOrder S; S.init(MROWS, 11264, G, bx);
          pg8::EpiSwiGLU E{ka0, second ? SS_2 : SS_IN};
#if !defined(DBG_ONLY) || DBG_ONLY == 0
          pg8::gemm_phase<pg8::EpiSwiGLU, pg8::StaticOrder, true, true>(lds, g, S, E);
#endif
        }
        GRID_BAR();
        { const KArg k = ka_fresh(ka0); unsigned char* ws = ka_ptr<unsigned char>(k, KA_WS);
          pg8::Gemm g{(const bf16*)(ws + WS_U), (const bf16*)(ws + WS_W + (size_t)l * W_LAYER + (second ? W_2D : W_1D)), MROWS, DM, DFF}; pg8::StaticOrder S; S.init(MROWS, DM, G, bx);
          pg8::EpiResid E{ka0, second ? SS_3 : SS_1, 0.5f};
#if !defined(DBG_ONLY) || DBG_ONLY == 1
          pg8::gemm_phase<pg8::EpiResid, pg8::StaticOrder, true, true>(lds, g, S, E);
#endif
        }
        GRID_BAR();
        if (!second) {
            { const KArg k = ka_fresh(ka0); unsigned char* ws = ka_ptr<unsigned char>(k, KA_WS);
              pg8::Gemm g{(const bf16*)(ws + WS_HB), (const bf16*)(ws + WS_W + (size_t)l * W_LAYER + W_IN), MROWS, NIN, DM}; pg8::StaticOrder S; S.init(MROWS, NIN, G, bx);
              pg8::EpiWin E{ka0, l};
#if !defined(DBG_ONLY) || DBG_ONLY == 2
              pg8::gemm_phase<pg8::EpiWin, pg8::StaticOrder, true, true>(lds, g, S, E);
#endif
            }
            GRID_BAR();
            { const KArg k = ka_fresh(ka0); unsigned char* ws = ka_ptr<unsigned char>(k, KA_WS);
              pg8::Gemm g{(const bf16*)(ws + WS_CQ), (const bf16*)(ws + WS_W + (size_t)l * W_LAYER + W_UQ), MROWS, 2048, opaque_i(512)}; pg8::StaticOrder S; S.init(MROWS, 2048, G, bx);
              pg8::EpiQB E{ka0, l, epiT};
#if !defined(DBG_ONLY) || DBG_ONLY == 3
              pg8::gemm_phase<pg8::EpiQB, pg8::StaticOrder, true, true>(lds, g, S, E);
#endif
            }
            { const KArg k = ka_fresh(ka0); unsigned char* ws = ka_ptr<unsigned char>(k, KA_WS);
              pg8::Gemm g{(const bf16*)(ws + WS_CKV), (const bf16*)(ws + WS_W + (size_t)l * W_LAYER + W_UKV), MROWS, 2048, opaque_i(256)}; pg8::StaticOrder S; S.init(MROWS, 2048, G, bx);
              pg8::EpiKV E{ka0, l, epiT};
#if !defined(DBG_ONLY) || DBG_ONLY == 4
              pg8::gemm_phase<pg8::EpiKV, pg8::StaticOrder, true, true>(lds, g, S, E);
#endif
            }
            { const KArg k = ka_fresh(ka0); unsigned char* ws = ka_ptr<unsigned char>(k, KA_WS);
              pg8::Gemm g{(const bf16*)(ws + WS_PB) + (size_t)l * MROWS * PLE, (const bf16*)(ws + WS_W + (size_t)l * W_LAYER + W_PP), MROWS, 2048, opaque_i(PLE)}; pg8::StaticOrder S; S.init(MROWS, 2048, G, bx);
              pg8::EpiStoreSsq E{ka0, SS_PP};
#if !defined(DBG_ONLY) || DBG_ONLY == 5
              pg8::gemm_phase<pg8::EpiStoreSsq, pg8::StaticOrder, true, true>(lds, g, S, E);
#endif
            }
            GRID_BAR();
            { const KArg k = ka_fresh(ka0); unsigned char* ws = ka_ptr<unsigned char>(k, KA_WS);
#ifndef DBG_NO_MLA
              for (int pi = vcu; pi < 256; pi += G) { const int bh = pi >> 4, s = pi & 15;
                att::mla_unit(bh >> 3, bh & 7, s, (const short*)(ws + WS_QB), (const short*)(ws + WS_KB), (const short*)(ws + WS_VB), (short*)(ws + WS_O), (att::lptr)lds);
                att::mla_unit(bh >> 3, bh & 7, 31 - s, (const short*)(ws + WS_QB), (const short*)(ws + WS_KB), (const short*)(ws + WS_VB), (short*)(ws + WS_O), (att::lptr)lds); }
#endif
#ifndef DBG_NO_SWA
              for (int si = vcu; si < 512; si += G) { const int b = si >> 8, kvh = (si >> 6) & 3, n = si & 63;
                att::swa_unit(b, kvh, n, (const short*)(ws + WS_QA), (const short*)(ws + WS_KA), (const short*)(ws + WS_VA), ka_ptr<const int>(k, 2), KIN(k, 11) + l * 16, (short*)(ws + WS_O), (att::lptr)lds); }
#endif
            }
            GRID_BAR();
            { const KArg k = ka_fresh(ka0); bf16* O = (bf16*)(ka_ptr<unsigned char>(k, KA_WS) + WS_O);
              for (int m = gw; m < MROWS; m += NGW) { const int half = lane >> 5, l32 = lane & 31; bf16* op = O + (size_t)m * DM + half * 1024 + l32 * 8;
                v4u w[4]; float s = 0.f;
#pragma unroll
                for (int j = 0; j < 4; ++j) { w[j] = *(const v4u*)(op + j * 256);
#pragma unroll
                    for (int e = 0; e < 4; ++e) { const float a = pg8::bf_lo(w[j][e]), b2 = pg8::bf_hi(w[j][e]); s += a * a + b2 * b2; } }
#pragma unroll
                for (int o = 1; o < 32; o <<= 1) s += __shfl_xor(s, o);
                const float r = pg8::rsq(s * (1.0f / 1024.0f) + EPS);
#pragma unroll
                for (int j = 0; j < 4; ++j) { v4u o;
#pragma unroll
                    for (int e = 0; e < 4; ++e) o[e] = pk2(pg8::bf_lo(w[j][e]) * r, pg8::bf_hi(w[j][e]) * r);
                    *(v4u*)(op + j * 256) = o; } } }
            GRID_BAR();
            { const KArg k = ka_fresh(ka0); unsigned char* ws = ka_ptr<unsigned char>(k, KA_WS);
              pg8::Gemm g{(const bf16*)(ws + WS_O), (const bf16*)(ws + WS_W + (size_t)l * W_LAYER + W_O), MROWS, DM, DM}; pg8::StaticOrder S; S.init(MROWS, DM, G, bx);
              pg8::EpiResid E{ka0, SS_2, 1.0f};
#if !defined(DBG_ONLY) || DBG_ONLY == 6
              pg8::gemm_phase<pg8::EpiResid, pg8::StaticOrder, true, true>(lds, g, S, E);
#endif
            }
            GRID_BAR();
        } else {
            { const KArg k = ka_fresh(ka0); unsigned char* ws = ka_ptr<unsigned char>(k, KA_WS);
              pg8::Gemm g{(const bf16*)(ws + WS_HB), (const bf16*)(ws + WS_W + (size_t)l * W_LAYER + W_PG), MROWS, DM, DM}; pg8::StaticOrder S; S.init(MROWS, DM, G, bx);
              pg8::EpiPle E{ka0, l};
#if !defined(DBG_ONLY) || DBG_ONLY == 7
              pg8::gemm_phase<pg8::EpiPle, pg8::StaticOrder, true, true>(lds, g, S, E);
#endif
            }
            if (hl + 1 < 2 * DEPTH) GRID_BAR();
        }
    }
}

extern "C" void kernel_launch(void* const* d_in, const int* in_sizes, int n_in, void* d_out, int out_size, void* d_ws, size_t ws_size, hipStream_t stream) {
    static int grid = 0;
    if (grid == 0) {
        if (n_in != 29 || out_size != MROWS * DM || ws_size < WS_END) { fprintf(stderr, "kernel_launch: unexpected shapes (n_in %d, out %d, ws %zu < %zu); nothing launched\n", n_in, out_size, ws_size, (size_t)WS_END); grid = -1; return; }
        int dev = 0, cus = 0, per_cu = 0;
        if (hipGetDevice(&dev) != hipSuccess || hipDeviceGetAttribute(&cus, hipDeviceAttributeMultiprocessorCount, dev) != hipSuccess) { grid = -1; return; }
        if (hipFuncSetAttribute((const void*)hybrid_fwd, hipFuncAttributeMaxDynamicSharedMemorySize, LDS_BYTES) != hipSuccess) { fprintf(stderr, "kernel_launch: hipFuncSetAttribute failed\n"); grid = -1; return; }
        if (hipOccupancyMaxActiveBlocksPerMultiprocessor(&per_cu, (const void*)hybrid_fwd, NWAVES * 64, LDS_BYTES) != hipSuccess || per_cu < 1)
            fprintf(stderr, "kernel_launch: note: occupancy query reports %d workgroups per CU\n", per_cu);
        (void)hipGetLastError();
        grid = cus;
    }
    if (grid < 0) return;
    if (hipMemsetAsync((char*)d_ws + WS_CTL, 0, ZERO_BYTES, stream) != hipSuccess) { fprintf(stderr, "kernel_launch: hipMemsetAsync failed\n"); return; }
    Args a{};
    for (int i = 0; i < 29; ++i) a.in[i] = d_in[i];
    a.out = (float*)d_out; a.ws = (unsigned char*)d_ws;
    hipLaunchKernelGGL(hybrid_fwd, dim3(grid), dim3(NWAVES * 64), LDS_BYTES, stream, a);
    const hipError_t le = hipPeekAtLastError();
    if (le != hipSuccess) fprintf(stderr, "kernel_launch: launch failed: %s\n", hipGetErrorName(le));
}
```

```cpp
#include <hip/hip_runtime.h>
#include <cstdio>
#include <cstdint>
#include <cmath>
__device__ __forceinline__ int lane_id() { int z = 0; asm volatile("" : "+v"(z)); return (int)__builtin_amdgcn_mbcnt_hi(~0u, __builtin_amdgcn_mbcnt_lo(~0u, (unsigned)z)); }
#define TIDX(wv) (((wv) << 6) | lane_id())
namespace pg8 {
#define PG8_LAS __attribute__((address_space(3)))
typedef unsigned short bf16_t;
typedef short bf16x8 __attribute__((ext_vector_type(8)));
typedef float f32x4 __attribute__((ext_vector_type(4)));
typedef unsigned u32x4 __attribute__((ext_vector_type(4)));
constexpr int BM = 256, BK = 64, HALF = 128, HTB = HALF * BK * 2  , STAGE_BYTES = 8 * HTB, NXCD = 8, WGM = 8;

__host__ __device__ __forceinline__ int lds_byte(int r, int c) { const int st = (r >> 4) * 2 + (c >> 5), rr = r & 15, cc = c & 31, ob = rr * 64 + cc * 2; return st * 1024 + (ob ^ (((ob >> 9) & 1) << 5)); }
__host__ __device__ __forceinline__ void stage_rc(int b, int& R, int& C) { const int st = b / 1024, sb = b % 1024, swz = sb ^ (((sb >> 9) & 1) << 5); R = (st >> 1) * 16 + swz / 64; C = (st & 1) * 32 + (swz % 64) / 2; }
__host__ __device__ __forceinline__ int perm32(int rho) { const int n = rho >> 4, i = rho & 15; return 8 * (i >> 2) + 4 * n + (i & 3); }

typedef int i32x4 __attribute__((ext_vector_type(4)));
template <bool I8> __device__ __forceinline__ f32x4 mma1(bf16x8 b, bf16x8 a, f32x4 c) {
    if constexpr (I8) return __builtin_bit_cast(f32x4, __builtin_amdgcn_mfma_i32_16x16x64_i8(__builtin_bit_cast(i32x4, b), __builtin_bit_cast(i32x4, a), __builtin_bit_cast(i32x4, c), 0, 0, 0));
    else return __builtin_amdgcn_mfma_f32_16x16x32_bf16(b, a, c, 0, 0, 0);
}
struct Unit { int pm, pn; };
struct Gemm { const bf16_t* A; const bf16_t* Bt; int M, N, K; };

struct StaticOrder {
    int nM, nN, nwg, G, c;
    __host__ __device__ void init(int M, int N, int G_, int c_) { nM = M / BM; nN = N / BM; nwg = nM * nN; G = G_; c = c_; }
    __host__ __device__ __forceinline__ bool next(int i, Unit& u) const {
        const long L = (long)i * G + c; if (L >= nwg) return false;
        int wgid = (int)L; { const int q = nwg / NXCD, r = nwg % NXCD, xcd = wgid % NXCD, off = wgid / NXCD; wgid = (xcd < r ? xcd * (q + 1) : r * (q + 1) + (xcd - r) * q) + off; }
        const int nig = WGM * nN, gid = wgid / nig, fm = gid * WGM, gsz = (nM - fm) < WGM ? (nM - fm) : WGM;
        u.pm = fm + ((wgid % nig) % gsz); u.pn = (wgid % nig) / gsz;
        { const int xc = (int)(L % NXCD); u.pn = (u.pn + (xc * nN) / NXCD) % nN; }
        return true;
    }
    __device__ __forceinline__ void a_ready(const Unit&) const {}
    __device__ __forceinline__ void done(const Unit&) const {}
};

typedef __bf16 bf16x2_t __attribute__((ext_vector_type(2)));
typedef float f32x2_t __attribute__((ext_vector_type(2)));
__device__ __forceinline__ unsigned cvt_pk_bf16(float lo, float hi) { const bf16x2_t r = __builtin_convertvector((f32x2_t){lo, hi}, bf16x2_t); return __builtin_bit_cast(unsigned, r); }
typedef float f32x2 __attribute__((ext_vector_type(2)));
template <class Epi, class Sched, bool ALIGN_EPI = false, bool SP2 = false, bool I8 = false>
__device__ __forceinline__ void gemm_phase(PG8_LAS unsigned char* lds, const Gemm g, const Sched& S, const Epi& E, int wv) {
    int tid_ = TIDX(wv);
    const int tid = tid_, wid = wv, lane = tid & 63, wr = wid >> 2, wc = wid & 3, fr = lane & 15, fq = lane >> 4;
    const int K = g.K, nt = K / BK;
    unsigned voffA[2], voffB[2];
#pragma unroll
    for (int i = 0; i < 2; ++i) { int R, C; stage_rc(tid * 16 + i * 8192, R, C); const int Rb = Epi::PERM ? ((R & ~31) + perm32(R & 31)) : R;
        voffA[i] = (unsigned)(R * K + C) * 2u; voffB[i] = (unsigned)(Rb * K + C) * 2u; }
    const size_t kstep = (size_t)(BK * 2);
    const size_t hstep = (size_t)HALF * K * 2;
    const size_t tstep = 2 * hstep;
    const unsigned ldsw = (unsigned)wid * 1024u;
    const int aoff = lds_byte(wr * 64 + fr, fq * 8), boff = lds_byte(wc * 32 + fr, fq * 8);
#define PG8_SA(b, h) (((b) * 2 + (h)) * HTB)
#define PG8_SB(b, h) ((4 + (b) * 2 + (h)) * HTB)
#define PG8_STAGE(bufoff, gbase, voff) do { _Pragma("unroll") for (int _i = 0; _i < 2; ++_i) \
        __builtin_amdgcn_global_load_lds((const unsigned*)((const char*)(gbase) + (voff)[_i]), (PG8_LAS unsigned*)(lds + (bufoff) + ldsw + _i * 8192), 16, 0, 0); } while (0)
#define PG8_LDA(dst, b, h) do { _Pragma("unroll") for (int m = 0; m < 4; ++m) _Pragma("unroll") for (int k = 0; k < 2; ++k) dst[m][k] = *(const PG8_LAS bf16x8*)(lds + PG8_SA(b, h) + aoff + m * 2048 + k * 1024); } while (0)
#define PG8_LDB(dst, b, h) do { _Pragma("unroll") for (int n = 0; n < 2; ++n) _Pragma("unroll") for (int k = 0; k < 2; ++k) dst[n][k] = *(const PG8_LAS bf16x8*)(lds + PG8_SB(b, h) + boff + n * 2048 + k * 1024); } while (0)
#define PG8_MMA(ai, bj, At, Bt) do { __builtin_amdgcn_s_setprio(1); _Pragma("unroll") for (int m = 0; m < 4; ++m) _Pragma("unroll") for (int n = 0; n < 2; ++n) _Pragma("unroll") for (int k = 0; k < 2; ++k) \
        acc[ai][bj][m][n] = mma1<I8>(Bt[n][k], At[m][k], acc[ai][bj][m][n]); __builtin_amdgcn_s_setprio(0); } while (0)
#define PG8_WAIT_V(n) asm volatile("s_waitcnt vmcnt(" #n ")" ::: "memory")
#define PG8_WAIT_L(n) asm volatile("s_waitcnt lgkmcnt(" #n ")" ::: "memory")
#define PG8_BAR __builtin_amdgcn_s_barrier()
#define PG8_SCHED __builtin_amdgcn_sched_barrier(0)
    Unit cur, nxt; int ui = 0;
    if (!S.next(0, cur)) return;
    f32x4 acc[2][2][4][2];
#pragma unroll
    for (int a = 0; a < 2; ++a)
#pragma unroll
        for (int b = 0; b < 2; ++b)
#pragma unroll
            for (int m = 0; m < 4; ++m)
#pragma unroll
                for (int n = 0; n < 2; ++n) acc[a][b][m][n] = (f32x4){0.f, 0.f, 0.f, 0.f};
    bf16x8 At[4][2], B0[2][2], B1[2][2];
    const char* cA = (const char*)g.A + (size_t)cur.pm * tstep; const char* cB = (const char*)g.Bt + (size_t)cur.pn * tstep;
    S.a_ready(cur);
    if constexpr (SP2) {
        PG8_STAGE(PG8_SB(0, 0), cB, voffB); PG8_STAGE(PG8_SB(0, 1), cB + hstep, voffB); PG8_STAGE(PG8_SA(0, 0), cA, voffA); PG8_STAGE(PG8_SA(0, 1), cA + hstep, voffA);
        if (wr == 1) PG8_BAR;
        PG8_WAIT_V(2); PG8_BAR;
        PG8_STAGE(PG8_SB(1, 0), cB + kstep, voffB); PG8_STAGE(PG8_SA(1, 0), cA + kstep, voffA); PG8_STAGE(PG8_SB(1, 1), cB + hstep + kstep, voffB);
        PG8_WAIT_V(6); PG8_BAR;
    } else {
        PG8_STAGE(PG8_SB(0, 0), cB, voffB); PG8_STAGE(PG8_SA(0, 0), cA, voffA); PG8_STAGE(PG8_SB(0, 1), cB + hstep, voffB); PG8_STAGE(PG8_SA(0, 1), cA + hstep, voffA);
        if (wr == 1) PG8_BAR;
        PG8_WAIT_V(4); PG8_BAR;
        PG8_STAGE(PG8_SB(1, 0), cB + kstep, voffB); PG8_STAGE(PG8_SA(1, 0), cA + kstep, voffA); PG8_STAGE(PG8_SB(1, 1), cB + hstep + kstep, voffB);
        PG8_WAIT_V(6); PG8_BAR;
    }
    for (;;) {
        const bool has_next = S.next(ui + 1, nxt);
        const char* nA = has_next ? (const char*)g.A + (size_t)nxt.pm * tstep : cA; const char* nB = has_next ? (const char*)g.Bt + (size_t)nxt.pn * tstep : cB;
        for (int t = 0; t < nt; t += 2) {
            const bool last = (t == nt - 2);
            const char* a1 = cA + (size_t)(t + 1) * kstep;
            const char* a2 = last ? nA : cA + (size_t)(t + 2) * kstep; const char* b2 = last ? nB : cB + (size_t)(t + 2) * kstep;
            const char* a3 = a2 + kstep; const char* b3 = b2 + kstep;
            if (last && has_next) S.a_ready(nxt);
            if constexpr (SP2) {
            PG8_LDB(B0, 0, 0); PG8_LDB(B1, 0, 1); PG8_SCHED; PG8_LDA(At, 0, 0); PG8_STAGE(PG8_SA(1, 1), a1 + hstep, voffA);
            PG8_WAIT_V(8); PG8_WAIT_L(0); PG8_BAR; PG8_MMA(0, 0, At, B0); PG8_MMA(0, 1, At, B1); PG8_BAR; PG8_SCHED;
            PG8_LDA(At, 0, 1); PG8_STAGE(PG8_SB(0, 0), b2, voffB); PG8_STAGE(PG8_SB(0, 1), b2 + hstep, voffB); PG8_STAGE(PG8_SA(0, 0), a2, voffA);
            PG8_WAIT_V(8); PG8_WAIT_L(0); PG8_BAR; PG8_MMA(1, 0, At, B0); PG8_MMA(1, 1, At, B1); PG8_BAR; PG8_SCHED;
            PG8_LDB(B0, 1, 0); PG8_LDB(B1, 1, 1); PG8_SCHED; PG8_LDA(At, 1, 0); PG8_STAGE(PG8_SA(0, 1), a2 + hstep, voffA);
            PG8_WAIT_V(8); PG8_WAIT_L(0); PG8_BAR; PG8_MMA(0, 0, At, B0); PG8_MMA(0, 1, At, B1); PG8_BAR; PG8_SCHED;
            PG8_LDA(At, 1, 1); PG8_STAGE(PG8_SB(1, 0), b3, voffB); PG8_STAGE(PG8_SB(1, 1), b3 + hstep, voffB); PG8_STAGE(PG8_SA(1, 0), a3, voffA);
            PG8_WAIT_V(8); PG8_WAIT_L(0); PG8_BAR; PG8_MMA(1, 0, At, B0); PG8_MMA(1, 1, At, B1); PG8_BAR; PG8_SCHED;
            } else {
            PG8_LDB(B0, 0, 0); PG8_SCHED; PG8_LDA(At, 0, 0); PG8_STAGE(PG8_SA(1, 1), a1 + hstep, voffA);
            PG8_WAIT_L(8); PG8_BAR; PG8_WAIT_L(0); PG8_MMA(0, 0, At, B0); PG8_BAR; PG8_SCHED;
            PG8_LDB(B1, 0, 1); PG8_STAGE(PG8_SB(0, 0), b2, voffB);
            PG8_BAR; PG8_WAIT_L(0); PG8_MMA(0, 1, At, B1); PG8_BAR;
            PG8_LDA(At, 0, 1); PG8_STAGE(PG8_SA(0, 0), a2, voffA);
            PG8_BAR; PG8_WAIT_L(0); PG8_MMA(1, 0, At, B0); PG8_BAR; PG8_SCHED;
            PG8_STAGE(PG8_SB(0, 1), b2 + hstep, voffB);
            PG8_WAIT_V(6); PG8_BAR; PG8_MMA(1, 1, At, B1); PG8_BAR;
            PG8_LDB(B0, 1, 0); PG8_SCHED; PG8_LDA(At, 1, 0); PG8_STAGE(PG8_SA(0, 1), a2 + hstep, voffA);
            PG8_WAIT_L(8); PG8_BAR; PG8_WAIT_L(0); PG8_MMA(0, 0, At, B0); PG8_BAR; PG8_SCHED;
            PG8_LDB(B1, 1, 1); PG8_STAGE(PG8_SB(1, 0), b3, voffB);
            PG8_BAR; PG8_WAIT_L(0); PG8_MMA(0, 1, At, B1); PG8_BAR;
            PG8_LDA(At, 1, 1); PG8_STAGE(PG8_SA(1, 0), a3, voffA);
            PG8_BAR; PG8_WAIT_L(0); PG8_MMA(1, 0, At, B0); PG8_BAR; PG8_SCHED;
            PG8_STAGE(PG8_SB(1, 1), b3 + hstep, voffB);
            PG8_WAIT_V(6); PG8_BAR; PG8_MMA(1, 1, At, B1); PG8_BAR;
            }
        }
        if constexpr (ALIGN_EPI) { if (wr == 0) PG8_BAR; }
        if constexpr (!Epi::AFTER_DRAIN) { int z_ = 0; asm volatile("" : "+v"(z_)); const int le_ = __builtin_amdgcn_mbcnt_hi(~0u, __builtin_amdgcn_mbcnt_lo(~0u, (unsigned)z_));
            if constexpr (Epi::WANTS_UI) E(acc, cur, ui, wr, wc, le_ & 15, le_ >> 4); else E(acc, cur, wr, wc, le_ & 15, le_ >> 4); S.done(cur); }
        if (!has_next) break;
#pragma unroll
        for (int a = 0; a < 2; ++a)
#pragma unroll
            for (int b = 0; b < 2; ++b)
#pragma unroll
                for (int m = 0; m < 4; ++m)
#pragma unroll
                    for (int n = 0; n < 2; ++n) acc[a][b][m][n] = (f32x4){0.f, 0.f, 0.f, 0.f};
        cur = nxt; cA = nA; cB = nB; ++ui;
        if constexpr (ALIGN_EPI) { if (wr == 1) PG8_BAR; }
    }
    PG8_WAIT_V(0);
    if constexpr (!ALIGN_EPI) { if (wr == 0) PG8_BAR; }
    PG8_BAR;
    if constexpr (Epi::AFTER_DRAIN) { E.fused(acc, cur, wr, wc, fr, fq, lds, wid, lane); S.done(cur); }
#undef PG8_SA
#undef PG8_SB
#undef PG8_STAGE
#undef PG8_LDA
#undef PG8_LDB
#undef PG8_MMA
#undef PG8_WAIT_V
#undef PG8_WAIT_L
#undef PG8_BAR
#undef PG8_SCHED
}
}
constexpr int BATCH = 2, SEQ = 8192, MROWS = BATCH * SEQ, DM = 2048, DFF = 5632, DEPTH = 4, PLE = 256;
constexpr int NIN = 2560;
constexpr int QB_PITCH = 1536, KB_PITCH = 1536, VB_PITCH = 1024, QA_PITCH = 1024, KA_PITCH = 256, VA_PITCH = 256;
constexpr float EPS = 1e-6f, LOG2E = 1.4426950408889634f;
constexpr float QA_SCALE = 0.125f * LOG2E;
constexpr float QB_SCALE = 0.07216878364870322f * LOG2E;

constexpr size_t MiB = 1u << 20;
constexpr size_t WS_CTL = 0;
constexpr size_t ZERO_BYTES = 1 * MiB;
constexpr size_t WS_SSKR = 4 * MiB;
constexpr size_t WS_KRR = 5 * MiB;
constexpr size_t WS_ROPEC = 9 * MiB, WS_ROPES = 11 * MiB;
constexpr size_t WS_HB = 13 * MiB;
constexpr size_t WS_U = 77 * MiB;
constexpr size_t WS_QA = 253 * MiB, WS_KA = 285 * MiB, WS_VA = 293 * MiB, WS_CQ = 301 * MiB, WS_CKV = 317 * MiB;
constexpr size_t WS_QB = 325 * MiB, WS_KB = 373 * MiB, WS_VB = 421 * MiB, WS_O = 453 * MiB, WS_PP = 517 * MiB, WS_PB = 581 * MiB;
constexpr size_t WS_W = 613 * MiB;
constexpr size_t W_1GU = 0, W_1D = 22 * MiB, W_IN = 33 * MiB, W_UQ = 43 * MiB, W_UKV = 45 * MiB, W_O = 46 * MiB, W_2GU = 54 * MiB, W_2D = 76 * MiB, W_PG = 87 * MiB, W_PP = 95 * MiB, W_LAYER = 96 * MiB;
constexpr size_t WS_HB2 = WS_W + DEPTH * W_LAYER;
constexpr size_t WS_STATS = WS_HB2 + 64 * MiB;
constexpr size_t WS_QA8 = WS_STATS + 16 * MiB;
constexpr size_t WS_RSQ8 = WS_QA8 + 32 * MiB;
constexpr size_t WS_WSC = WS_RSQ8 + 1 * MiB;
constexpr size_t WS_QU8 = WS_WSC + 1 * MiB;
constexpr size_t WS_RSU = WS_QU8 + 88 * MiB;
constexpr size_t WS_WSCD = WS_RSU + 1 * MiB;
constexpr size_t WS_WSCP = WS_WSCD + 1 * MiB;
constexpr size_t WS_PP2 = WS_WSCP + 1 * MiB;
constexpr size_t WS_END = WS_PP2 + 64 * MiB;
static_assert((size_t)11264 * 2048 == 22 * MiB && (size_t)2048 * 5632 == 11 * MiB && (size_t)NIN * 2048 * 2 == 10 * MiB, "weight sizes");
enum { SS_IN = 0, SS_1 = 1, SS_CQ = 2, SS_CKV = 3, SS_2 = 4, SS_3 = 5, SS_PP = 6, SS_PP2 = 7 };
typedef __attribute__((address_space(4))) const unsigned long long* KArg;
constexpr int KA_OUT = 29, KA_WS = 30;
__device__ __forceinline__ KArg ka_fresh(KArg k) { asm volatile("" : "+s"(k)); return k; }
template <class T> __device__ __forceinline__ T* ka_ptr(KArg k, int i) { return (T*)(__attribute__((address_space(1))) T*)k[i]; }
__device__ __forceinline__ float* ka_stats(KArg k, int slot) { return (float*)(ka_ptr<unsigned char>(k, KA_WS) + WS_STATS) + (size_t)slot * MROWS * 32; }

namespace pg8 {
typedef float f32x2 __attribute__((ext_vector_type(2)));
typedef unsigned u32x2 __attribute__((ext_vector_type(2)));
__device__ __forceinline__ float rsq(float x) { return __builtin_amdgcn_rsqf(x); }
__device__ __forceinline__ float dot4(f32x4 a) { return (a[0] * a[0] + a[1] * a[1]) + (a[2] * a[2] + a[3] * a[3]); }
__device__ __forceinline__ u32x4 pack8(f32x4 a, f32x4 b) { u32x4 w; w.x = cvt_pk_bf16(a[0], a[1]); w.y = cvt_pk_bf16(a[2], a[3]); w.z = cvt_pk_bf16(b[0], b[1]); w.w = cvt_pk_bf16(b[2], b[3]); return w; }
__device__ __forceinline__ float silu1(float x) { return x * __builtin_amdgcn_rcpf(1.0f + __builtin_amdgcn_exp2f(-x * LOG2E)); }
__device__ __forceinline__ float sigm1(float x) { return __builtin_amdgcn_rcpf(1.0f + __builtin_amdgcn_exp2f(-x * LOG2E)); }
__device__ __forceinline__ float bf_lo(unsigned w) { return __uint_as_float(w << 16); }
__device__ __forceinline__ float bf_hi(unsigned w) { return __uint_as_float(w & 0xffff0000u); }
__device__ __forceinline__ float ssq32(const float* slot, int row, int fq) { const f32x4 a = *(const f32x4*)(slot + (size_t)row * 32 + fq * 8), b = *(const f32x4*)(slot + (size_t)row * 32 + fq * 8 + 4);
    float s = ((a[0] + a[1]) + (a[2] + a[3])) + ((b[0] + b[1]) + (b[2] + b[3])); s += __shfl_xor(s, 16); s += __shfl_xor(s, 32); return s; }
__device__ __forceinline__ float rowsum_fq(float s) { s += __shfl_xor(s, 16); s += __shfl_xor(s, 32); return s; }


struct EpiSwiGLU {
    static constexpr bool PERM = true, AFTER_DRAIN = false, WANTS_UI = false;
    KArg ka; int slot_in; const PG8_LAS float* rs_tab; bf16_t* Ubase;
    __device__ __forceinline__ void operator()(const f32x4 (&acc)[2][2][4][2], const Unit& u, int wr, int wc_, int fr_, int fq_) const {
        int fr = fr_, fq = fq_, wc = wc_; asm volatile("" : "+v"(fr), "+v"(fq), "+s"(wc));
        const int row0 = u.pm * BM + wr * 64 + fr, col0 = u.pn * 128 + wc * 32 + 8 * fq;
        bf16_t* U = Ubase; asm volatile("" : "+s"(U));
        const float* ssq = nullptr; if (!rs_tab) ssq = ka_stats(ka_fresh(ka), slot_in);
#pragma unroll
        for (int ai = 0; ai < 2; ++ai)
#pragma unroll
            for (int m = 0; m < 4; ++m) { const int row = row0 + ai * HALF + m * 16; const float rs = rs_tab ? rs_tab[ai * HALF + wr * 64 + m * 16 + fr] : rsq(ssq32(ssq, row, fq) * (1.0f / DM) + EPS);
                f32x4 o[2];
#pragma unroll
                for (int n = 0; n < 2; ++n) { const f32x4 g = acc[ai][0][m][n] * rs, up = acc[ai][1][m][n] * rs;
                    o[n] = (f32x4){silu1(g[0]) * up[0], silu1(g[1]) * up[1], silu1(g[2]) * up[2], silu1(g[3]) * up[3]}; }
                *(u32x4*)(U + (size_t)row * DFF + col0) = pack8(o[0], o[1]); }
    }
};
struct EpiSwiGLU8 {
    static constexpr bool PERM = true, AFTER_DRAIN = false, WANTS_UI = true;
    KArg ka; const PG8_LAS float* rs_tab; const PG8_LAS float* cs_tab; size_t wsc_off; bf16_t* Ubase;
    __device__ __forceinline__ void operator()(const f32x4 (&acc)[2][2][4][2], const Unit& u, int ui, int wr, int wc_, int fr_, int fq_) const {
        int fr = fr_, fq = fq_, wc = wc_; asm volatile("" : "+v"(fr), "+v"(fq), "+s"(wc));
        const int row0 = u.pm * BM + wr * 64 + fr, col0 = u.pn * 128 + wc * 32 + 8 * fq;
        bf16_t* U = Ubase; asm volatile("" : "+s"(U));
        f32x4 cs[2][2];
        if (cs_tab) {
#pragma unroll
            for (int bj = 0; bj < 2; ++bj)
#pragma unroll
                for (int n = 0; n < 2; ++n) cs[bj][n] = *(const PG8_LAS f32x4*)(cs_tab + ui * 256 + bj * 128 + wc * 32 + 8 * fq + 4 * n);
        } else { const float* w = (const float*)(ka_ptr<unsigned char>(ka_fresh(ka), KA_WS) + wsc_off) + (size_t)u.pn * 256;
#pragma unroll
            for (int bj = 0; bj < 2; ++bj)
#pragma unroll
                for (int n = 0; n < 2; ++n) cs[bj][n] = *(const f32x4*)(w + bj * 128 + wc * 32 + 8 * fq + 4 * n); }
        const float* rsg = nullptr; if (!rs_tab) rsg = (const float*)(ka_ptr<unsigned char>(ka_fresh(ka), KA_WS) + WS_RSQ8);
#pragma unroll
        for (int ai = 0; ai < 2; ++ai)
#pragma unroll
            for (int m = 0; m < 4; ++m) { const int row = row0 + ai * HALF + m * 16; const float rs = rs_tab ? rs_tab[ai * HALF + wr * 64 + m * 16 + fr] : rsg[row];
                f32x4 o[2];
#pragma unroll
                for (int n = 0; n < 2; ++n) { const i32x4 gi = __builtin_bit_cast(i32x4, acc[ai][0][m][n]), vi = __builtin_bit_cast(i32x4, acc[ai][1][m][n]);
                    const f32x4 gf = (f32x4){(float)gi[0], (float)gi[1], (float)gi[2], (float)gi[3]}, sg = cs[0][n] * rs;
                    const f32x4 g = gf * sg, t = gf * (sg * -LOG2E), up = (f32x4){(float)vi[0], (float)vi[1], (float)vi[2], (float)vi[3]} * (cs[1][n] * rs), gu = g * up;
                    o[n] = (f32x4){gu[0] * __builtin_amdgcn_rcpf(1.0f + __builtin_amdgcn_exp2f(t[0])), gu[1] * __builtin_amdgcn_rcpf(1.0f + __builtin_amdgcn_exp2f(t[1])),
                                   gu[2] * __builtin_amdgcn_rcpf(1.0f + __builtin_amdgcn_exp2f(t[2])), gu[3] * __builtin_amdgcn_rcpf(1.0f + __builtin_amdgcn_exp2f(t[3]))}; }
                *(u32x4*)(U + (size_t)row * DFF + col0) = pack8(o[0], o[1]); }
    }
};
struct EpiResid {
    static constexpr bool PERM = true, AFTER_DRAIN = false, WANTS_UI = false;
    KArg ka; int slot_out; float scale; size_t src_off, dst_off;
    __device__ __forceinline__ void operator()(const f32x4 (&acc)[2][2][4][2], const Unit& u, int wr, int wc_, int fr_, int fq_) const {
        int fr = fr_, fq = fq_, wc = wc_; asm volatile("" : "+v"(fr), "+v"(fq), "+s"(wc));
        const int row0 = u.pm * BM + wr * 64 + fr, col0 = u.pn * BM + wc * 32 + 8 * fq;
        const KArg k = ka_fresh(ka); const bf16_t* XS = (const bf16_t*)(ka_ptr<unsigned char>(k, KA_WS) + src_off); bf16_t* XD = (bf16_t*)(ka_ptr<unsigned char>(k, KA_WS) + dst_off); float* ssq_out = ka_stats(k, slot_out);
#pragma unroll
        for (int ai = 0; ai < 2; ++ai) {
            u32x4 xin[4][2];
#pragma unroll
            for (int m = 0; m < 4; ++m)
#pragma unroll
                for (int bj = 0; bj < 2; ++bj) xin[m][bj] = *(const u32x4*)(XS + (size_t)(row0 + ai * HALF + m * 16) * DM + col0 + bj * HALF);
            asm volatile("s_waitcnt vmcnt(0)" ::: "memory");
#pragma unroll
            for (int m = 0; m < 4; ++m) { const int row = row0 + ai * HALF + m * 16; float part = 0.f;
#pragma unroll
                for (int bj = 0; bj < 2; ++bj) { const size_t off = (size_t)row * DM + col0 + bj * HALF; const u32x4 xw = xin[m][bj];
                    f32x4 x0 = (f32x4){bf_lo(xw.x), bf_hi(xw.x), bf_lo(xw.y), bf_hi(xw.y)}, x1 = (f32x4){bf_lo(xw.z), bf_hi(xw.z), bf_lo(xw.w), bf_hi(xw.w)};
                    x0 = x0 + acc[ai][bj][m][0] * scale; x1 = x1 + acc[ai][bj][m][1] * scale;
                    *(u32x4*)(XD + off) = pack8(x0, x1);
                    part += dot4(x0) + dot4(x1); }
                if (slot_out >= 0) { part = rowsum_fq(part); if (fq == 0) ssq_out[(size_t)row * 32 + u.pn * 4 + wc] = part; } } }
    }
};
struct EpiResid8 {
    static constexpr bool PERM = true, AFTER_DRAIN = false, WANTS_UI = false;
    KArg ka; int slot_out; float scale; size_t src_off, dst_off, wsc_off;
    __device__ __forceinline__ void operator()(const f32x4 (&acc)[2][2][4][2], const Unit& u, int wr, int wc_, int fr_, int fq_) const {
        int fr = fr_, fq = fq_, wc = wc_; asm volatile("" : "+v"(fr), "+v"(fq), "+s"(wc));
        const int row0 = u.pm * BM + wr * 64 + fr, col0 = u.pn * BM + wc * 32 + 8 * fq;
        const KArg k = ka_fresh(ka); const bf16_t* XS = (const bf16_t*)(ka_ptr<unsigned char>(k, KA_WS) + src_off); bf16_t* XD = (bf16_t*)(ka_ptr<unsigned char>(k, KA_WS) + dst_off); float* ssq_out = ka_stats(k, slot_out);
        const float* rsu = (const float*)(ka_ptr<unsigned char>(k, KA_WS) + WS_RSU); const float* wsc = (const float*)(ka_ptr<unsigned char>(k, KA_WS) + wsc_off);
        f32x4 cs[2][2];
#pragma unroll
        for (int bj = 0; bj < 2; ++bj)
#pragma unroll
            for (int n = 0; n < 2; ++n) cs[bj][n] = *(const f32x4*)(wsc + col0 + bj * HALF + 4 * n);
#pragma unroll
        for (int ai = 0; ai < 2; ++ai) {
            u32x4 xin[4][2]; float rs[4];
#pragma unroll
            for (int m = 0; m < 4; ++m) { rs[m] = rsu[row0 + ai * HALF + m * 16];
#pragma unroll
                for (int bj = 0; bj < 2; ++bj) xin[m][bj] = *(const u32x4*)(XS + (size_t)(row0 + ai * HALF + m * 16) * DM + col0 + bj * HALF); }
            asm volatile("s_waitcnt vmcnt(0)" ::: "memory");
#pragma unroll
            for (int m = 0; m < 4; ++m) { const int row = row0 + ai * HALF + m * 16; float part = 0.f; const float rsc = rs[m] * scale;
#pragma unroll
                for (int bj = 0; bj < 2; ++bj) { const size_t off = (size_t)row * DM + col0 + bj * HALF; const u32x4 xw = xin[m][bj];
                    f32x4 x0 = (f32x4){bf_lo(xw.x), bf_hi(xw.x), bf_lo(xw.y), bf_hi(xw.y)}, x1 = (f32x4){bf_lo(xw.z), bf_hi(xw.z), bf_lo(xw.w), bf_hi(xw.w)};
                    const i32x4 a0 = __builtin_bit_cast(i32x4, acc[ai][bj][m][0]), a1 = __builtin_bit_cast(i32x4, acc[ai][bj][m][1]);
                    x0 = x0 + (f32x4){(float)a0[0], (float)a0[1], (float)a0[2], (float)a0[3]} * (cs[bj][0] * rsc); x1 = x1 + (f32x4){(float)a1[0], (float)a1[1], (float)a1[2], (float)a1[3]} * (cs[bj][1] * rsc);
                    *(u32x4*)(XD + off) = pack8(x0, x1);
                    part += dot4(x0) + dot4(x1); }
                if (slot_out >= 0) { part = rowsum_fq(part); if (fq == 0) ssq_out[(size_t)row * 32 + u.pn * 4 + wc] = part; } } }
    }
};
struct EpiStoreSsq {
    static constexpr bool PERM = true, AFTER_DRAIN = false, WANTS_UI = false;
    KArg ka; int slot_out; size_t out_off;
    __device__ __forceinline__ void operator()(const f32x4 (&acc)[2][2][4][2], const Unit& u, int wr, int wc_, int fr_, int fq_) const {
        int fr = fr_, fq = fq_, wc = wc_; asm volatile("" : "+v"(fr), "+v"(fq), "+s"(wc));
        const int row0 = u.pm * BM + wr * 64 + fr, col0 = u.pn * BM + wc * 32 + 8 * fq;
        const KArg k = ka_fresh(ka); bf16_t* O = (bf16_t*)(ka_ptr<unsigned char>(k, KA_WS) + out_off); constexpr int ldc = DM; float* ssq_out = ka_stats(k, slot_out);
#pragma unroll
        for (int ai = 0; ai < 2; ++ai)
#pragma unroll
            for (int m = 0; m < 4; ++m) { const int row = row0 + ai * HALF + m * 16; float part = 0.f;
#pragma unroll
                for (int bj = 0; bj < 2; ++bj) { const f32x4 v0 = acc[ai][bj][m][0], v1 = acc[ai][bj][m][1];
                    *(u32x4*)(O + (size_t)row * ldc + col0 + bj * HALF) = pack8(v0, v1); part += dot4(v0) + dot4(v1); }
                part = rowsum_fq(part);
                if (fq == 0) ssq_out[(size_t)row * 32 + u.pn * 4 + wc] = part; }
    }
};
struct EpiWin {
    static constexpr bool PERM = true, AFTER_DRAIN = false, WANTS_UI = false;
    KArg ka; int l; const PG8_LAS float* rs_tab;
    __device__ __forceinline__ void operator()(const f32x4 (&acc)[2][2][4][2], const Unit& u, int wr, int wc_, int fr_, int fq_) const {
        int fr = fr_, fq = fq_, wc = wc_; asm volatile("" : "+v"(fr), "+v"(fq), "+s"(wc));
        const int row0 = u.pm * BM + wr * 64 + fr, pn = u.pn;
        const KArg k = ka_fresh(ka); unsigned char* ws = ka_ptr<unsigned char>(k, KA_WS); const float* ssq_in = ka_stats(k, SS_1);
        if (pn <= 4) {
            const float* gq = ka_ptr<const float>(k, 9) + l * 64; const float* gk = ka_ptr<const float>(k, 10) + l * 64; bf16_t* QA = (bf16_t*)(ws + WS_QA); bf16_t* KA = (bf16_t*)(ws + WS_KA);
            const float* gain = pn < 4 ? gq : gk; const float extra = pn < 4 ? QA_SCALE : 1.0f;
            bf16_t* dst = pn < 4 ? QA + (4 * pn + wc) * 64 : KA + wc * 64; const int pitch = pn < 4 ? QA_PITCH : KA_PITCH;
            f32x4 g[2][2];
#pragma unroll
            for (int bj = 0; bj < 2; ++bj)
#pragma unroll
                for (int n = 0; n < 2; ++n) g[bj][n] = *(const f32x4*)(gain + 32 * bj + 8 * fq + 4 * n);
#pragma unroll
            for (int ai = 0; ai < 2; ++ai)
#pragma unroll
                for (int m = 0; m < 4; ++m) { const int row = row0 + ai * HALF + m * 16; const float rs = rs_tab ? rs_tab[ai * HALF + wr * 64 + m * 16 + fr] : rsq(ssq32(ssq_in, row, fq) * (1.0f / DM) + EPS);
                    float ss = 0.f;
#pragma unroll
                    for (int bj = 0; bj < 2; ++bj)
#pragma unroll
                        for (int n = 0; n < 2; ++n) ss += dot4(acc[ai][bj][m][n]);
                    ss = rowsum_fq(ss) * rs * rs;
                    const float sc = rsq(ss * (1.0f / 64.0f) + EPS) * extra * rs;
#pragma unroll
                    for (int bj = 0; bj < 2; ++bj)
                        *(u32x4*)(dst + (size_t)row * pitch + 32 * bj + 8 * fq) = pack8(acc[ai][bj][m][0] * sc * g[bj][0], acc[ai][bj][m][1] * sc * g[bj][1]); }
        } else if (pn <= 8) {
            bf16_t* dst; int pitch; float* sq; bf16_t* VA = (bf16_t*)(ws + WS_VA); bf16_t* CQ = (bf16_t*)(ws + WS_CQ); bf16_t* CKV = (bf16_t*)(ws + WS_CKV);
            float* ssq_cq = ka_stats(k, SS_CQ); float* ssq_ckv = ka_stats(k, SS_CKV);
            if (pn == 5) { dst = VA; pitch = VA_PITCH; sq = nullptr; } else if (pn <= 7) { dst = CQ + (pn - 6) * 256; pitch = 512; sq = ssq_cq; } else { dst = CKV; pitch = 256; sq = ssq_ckv; }
#pragma unroll
            for (int ai = 0; ai < 2; ++ai)
#pragma unroll
                for (int m = 0; m < 4; ++m) { const int row = row0 + ai * HALF + m * 16; const float rs = rs_tab ? rs_tab[ai * HALF + wr * 64 + m * 16 + fr] : rsq(ssq32(ssq_in, row, fq) * (1.0f / DM) + EPS); float part = 0.f;
#pragma unroll
                    for (int bj = 0; bj < 2; ++bj) { const f32x4 v0 = acc[ai][bj][m][0] * rs, v1 = acc[ai][bj][m][1] * rs;
                        *(u32x4*)(dst + (size_t)row * pitch + bj * HALF + wc * 32 + 8 * fq) = pack8(v0, v1); part += dot4(v0) + dot4(v1); }
                    part = rowsum_fq(part);
                    if (sq != nullptr && fq == 0) sq[(size_t)row * 32 + (pn == 7 ? 4 : 0) + wc] = part; }
        } else if (wc == 0) {
            const float* gkr = ka_ptr<const float>(k, 17) + l * 192 + 128; float* SSKR = (float*)(ws + WS_SSKR); float* KRR = (float*)(ws + WS_KRR);
            const float* ropec = (const float*)(ws + WS_ROPEC); const float* ropes = (const float*)(ws + WS_ROPES);
            f32x4 g1[2], g2[2];
#pragma unroll
            for (int n = 0; n < 2; ++n) { g1[n] = *(const f32x4*)(gkr + 8 * fq + 4 * n); g2[n] = *(const f32x4*)(gkr + 32 + 8 * fq + 4 * n); }
#pragma unroll
            for (int am = 0; am < 4; ++am) { const int ai = am >> 1, m0 = 2 * (am & 1);
                f32x4 cs[2][2], sn[2][2];
#pragma unroll
                for (int mm = 0; mm < 2; ++mm)
#pragma unroll
                    for (int n = 0; n < 2; ++n) { const size_t ro = (size_t)(row0 + ai * HALF + (m0 + mm) * 16) * 32 + 8 * fq + 4 * n; cs[mm][n] = *(const f32x4*)(ropec + ro); sn[mm][n] = *(const f32x4*)(ropes + ro); }
                asm volatile("s_waitcnt vmcnt(0)" ::: "memory");
#pragma unroll
                for (int mm = 0; mm < 2; ++mm) { const int m = m0 + mm, row = row0 + ai * HALF + m * 16; const float rs = rs_tab ? rs_tab[ai * HALF + wr * 64 + m * 16 + fr] : rsq(ssq32(ssq_in, row, fq) * (1.0f / DM) + EPS);
                    float ss = 0.f;
#pragma unroll
                    for (int bj = 0; bj < 2; ++bj)
#pragma unroll
                        for (int n = 0; n < 2; ++n) ss += dot4(acc[ai][bj][m][n]);
                    ss = rowsum_fq(ss) * rs * rs;
                    if (fq == 0) SSKR[row] = ss;
#pragma unroll
                    for (int n = 0; n < 2; ++n) { const f32x4 c = cs[mm][n], s = sn[mm][n];
                        const f32x4 x1 = acc[ai][0][m][n] * rs * g1[n], x2 = acc[ai][1][m][n] * rs * g2[n];
                        *(f32x4*)(KRR + (size_t)row * 64 + 8 * fq + 4 * n) = x1 * c - x2 * s;
                        *(f32x4*)(KRR + (size_t)row * 64 + 32 + 8 * fq + 4 * n) = x2 * c + x1 * s; } } }
        }
    }
};
struct EpiQB {
    static constexpr bool PERM = true, AFTER_DRAIN = false, WANTS_UI = false;
    KArg ka; int l; PG8_LAS float* T;
    __device__ __forceinline__ void operator()(const f32x4 (&acc)[2][2][4][2], const Unit& u, int wr, int wc_, int fr_, int fq_) const {
        int fr = fr_, fq = fq_, wc = wc_; asm volatile("" : "+v"(fr), "+v"(fq), "+s"(wc));
        const int row0 = u.pm * BM + wr * 64 + fr, h = u.pn;
        const KArg k = ka_fresh(ka); unsigned char* ws = ka_ptr<unsigned char>(k, KA_WS); const float* ssq_cq = ka_stats(k, SS_CQ); const float* gqn = ka_ptr<const float>(k, 16) + l * 192;
        bf16_t* QB = (bf16_t*)(ws + WS_QB); const float* ropec = (const float*)(ws + WS_ROPEC); const float* ropes = (const float*)(ws + WS_ROPES);
        float rs[2][4]; f32x2 sq[2][4]; f32x4 g[2][2];
#pragma unroll
        for (int ai = 0; ai < 2; ++ai)
#pragma unroll
            for (int m = 0; m < 4; ++m) sq[ai][m] = *(const f32x2*)(ssq_cq + (size_t)(row0 + ai * HALF + m * 16) * 32 + 2 * fq);
        if (wc < 3) {
#pragma unroll
            for (int bj = 0; bj < 2; ++bj)
#pragma unroll
                for (int n = 0; n < 2; ++n) g[bj][n] = *(const f32x4*)(gqn + 64 * wc + 32 * bj + 8 * fq + 4 * n);
        }
#pragma unroll
        for (int ai = 0; ai < 2; ++ai)
#pragma unroll
            for (int m = 0; m < 4; ++m) { rs[ai][m] = rsq(rowsum_fq(sq[ai][m][0] + sq[ai][m][1]) * (1.0f / 512.0f) + EPS);
                float ss = 0.f;
#pragma unroll
                for (int bj = 0; bj < 2; ++bj)
#pragma unroll
                    for (int n = 0; n < 2; ++n) ss += dot4(acc[ai][bj][m][n]);
                ss = rowsum_fq(ss) * rs[ai][m] * rs[ai][m];
                if (fq == 0) T[(ai * HALF + wr * 64 + m * 16 + fr) * 4 + wc] = ss; }
        asm volatile("s_waitcnt lgkmcnt(0)" ::: "memory"); __builtin_amdgcn_s_barrier(); asm volatile("" ::: "memory");
        if (wc < 3) {
#pragma unroll
            for (int ai = 0; ai < 2; ++ai)
#pragma unroll
                for (int m = 0; m < 4; ++m) { const int row = row0 + ai * HALF + m * 16; const f32x4 t = *(const PG8_LAS f32x4*)(T + (ai * HALF + wr * 64 + m * 16 + fr) * 4);
                    const float sc = rsq(((t[0] + t[1]) + (t[2] + t[3])) * (1.0f / 192.0f) + EPS) * QB_SCALE * rs[ai][m];
#pragma unroll
                    for (int bj = 0; bj < 2; ++bj)
                        *(u32x4*)(QB + (size_t)row * QB_PITCH + h * 192 + 64 * wc + 32 * bj + 8 * fq) = pack8(acc[ai][bj][m][0] * sc * g[bj][0], acc[ai][bj][m][1] * sc * g[bj][1]); }
        }
    }
};
struct EpiKV {
    static constexpr bool PERM = true, AFTER_DRAIN = false, WANTS_UI = false;
    KArg ka; int l; PG8_LAS float* T;
    __device__ __forceinline__ void operator()(const f32x4 (&acc)[2][2][4][2], const Unit& u, int wr, int wc_, int fr_, int fq_) const {
        int fr = fr_, fq = fq_, wc = wc_; asm volatile("" : "+v"(fr), "+v"(fq), "+s"(wc));
        const int row0 = u.pm * BM + wr * 64 + fr, h = u.pn;
        const KArg k = ka_fresh(ka); unsigned char* ws = ka_ptr<unsigned char>(k, KA_WS); const float* ssq_ckv = ka_stats(k, SS_CKV); const float* gkn = ka_ptr<const float>(k, 17) + l * 192;
        bf16_t* KB = (bf16_t*)(ws + WS_KB); bf16_t* VB = (bf16_t*)(ws + WS_VB); const float* SSKR = (const float*)(ws + WS_SSKR); const float* KRR = (const float*)(ws + WS_KRR);
        float rs[2][4], skr[2][4]; f32x4 krv[2][4], g[2];
#pragma unroll
        for (int n = 0; n < 2; ++n) g[n] = *(const f32x4*)(gkn + 32 * wc + 8 * fq + 4 * n);
#pragma unroll
        for (int ai = 0; ai < 2; ++ai)
#pragma unroll
            for (int m = 0; m < 4; ++m) { const int row = row0 + ai * HALF + m * 16; skr[ai][m] = SSKR[row]; krv[ai][m] = *(const f32x4*)(KRR + (size_t)row * 64 + 16 * wc + 4 * fq); }
#pragma unroll
        for (int ai = 0; ai < 2; ++ai)
#pragma unroll
            for (int m = 0; m < 4; ++m) { const int row = row0 + ai * HALF + m * 16; { const f32x4 a_ = *(const f32x4*)(ssq_ckv + (size_t)row * 32); rs[ai][m] = rsq(((a_[0] + a_[1]) + (a_[2] + a_[3])) * (1.0f / 256.0f) + EPS); }
                float ss = dot4(acc[ai][0][m][0]) + dot4(acc[ai][0][m][1]);
                ss = rowsum_fq(ss) * rs[ai][m] * rs[ai][m];
                if (fq == 0) T[(ai * HALF + wr * 64 + m * 16 + fr) * 4 + wc] = ss; }
        asm volatile("s_waitcnt lgkmcnt(0)" ::: "memory"); __builtin_amdgcn_s_barrier(); asm volatile("" ::: "memory");
#pragma unroll
        for (int ai = 0; ai < 2; ++ai)
#pragma unroll
            for (int m = 0; m < 4; ++m) { const int row = row0 + ai * HALF + m * 16; const f32x4 t = *(const PG8_LAS f32x4*)(T + (ai * HALF + wr * 64 + m * 16 + fr) * 4);
                const float sh = rsq((((t[0] + t[1]) + (t[2] + t[3])) + skr[ai][m]) * (1.0f / 192.0f) + EPS), sc = sh * rs[ai][m];
                *(u32x4*)(KB + (size_t)row * KB_PITCH + h * 192 + 32 * wc + 8 * fq) = pack8(acc[ai][0][m][0] * sc * g[0], acc[ai][0][m][1] * sc * g[1]);
                *(u32x4*)(VB + (size_t)row * VB_PITCH + h * 128 + 32 * wc + 8 * fq) = pack8(acc[ai][1][m][0] * rs[ai][m], acc[ai][1][m][1] * rs[ai][m]);
                const f32x4 kr = krv[ai][m] * sh;
                u32x2 w; w.x = cvt_pk_bf16(kr[0], kr[1]); w.y = cvt_pk_bf16(kr[2], kr[3]);
                *(u32x2*)(KB + (size_t)row * KB_PITCH + h * 192 + 128 + 16 * wc + 4 * fq) = w; }
    }
};
struct EpiPle {
    static constexpr bool PERM = true, AFTER_DRAIN = false, WANTS_UI = false;
    KArg ka; int l; const PG8_LAS float* rs_tab; size_t wsc_off, pp_off; int pp_slot;
    __device__ __forceinline__ void operator()(const f32x4 (&acc)[2][2][4][2], const Unit& u, int wr, int wc_, int fr_, int fq_) const {
        int fr = fr_, fq = fq_, wc = wc_; asm volatile("" : "+v"(fr), "+v"(fq), "+s"(wc));
        const int row0 = u.pm * BM + wr * 64 + fr, col0 = u.pn * BM + wc * 32 + 8 * fq;
        const KArg k = ka_fresh(ka); unsigned char* ws = ka_ptr<unsigned char>(k, KA_WS); float* OUT = ka_ptr<float>(k, KA_OUT); const bf16_t* XS = (const bf16_t*)(ws + WS_HB); bf16_t* XD = (bf16_t*)(ws + WS_HB2); const bf16_t* PP = (const bf16_t*)(ws + pp_off);
        const float* rsq8 = (const float*)(ws + WS_RSQ8); const float* wsc = (const float*)(ws + wsc_off); const float* ssq_pp = ka_stats(k, pp_slot); const float* gpp = ka_ptr<const float>(k, 26) + l * DM;
        f32x4 g[2][2], cw[2][2];
#pragma unroll
        for (int bj = 0; bj < 2; ++bj)
#pragma unroll
            for (int n = 0; n < 2; ++n) { g[bj][n] = *(const f32x4*)(gpp + col0 + bj * HALF + 4 * n); cw[bj][n] = *(const f32x4*)(wsc + col0 + bj * HALF + 4 * n); }
#pragma unroll
        for (int am = 0; am < 4; ++am) { const int ai = am >> 1, m0 = 2 * (am & 1);
            u32x4 xin[2][2], pin[2][2];
#pragma unroll
            for (int mm = 0; mm < 2; ++mm)
#pragma unroll
                for (int bj = 0; bj < 2; ++bj) { const size_t off = (size_t)(row0 + ai * HALF + (m0 + mm) * 16) * DM + col0 + bj * HALF; xin[mm][bj] = *(const u32x4*)(XS + off); pin[mm][bj] = *(const u32x4*)(PP + off); }
            asm volatile("s_waitcnt vmcnt(0)" ::: "memory");
#pragma unroll
            for (int mm = 0; mm < 2; ++mm) { const int m = m0 + mm, row = row0 + ai * HALF + m * 16; const int rl = ai * HALF + wr * 64 + m * 16 + fr; const float rs = rs_tab ? rs_tab[rl] : rsq8[row], rp = rs_tab ? rs_tab[256 + rl] : rsq(ssq32(ssq_pp, row, fq) * (1.0f / DM) + EPS);
#pragma unroll
                for (int bj = 0; bj < 2; ++bj) { const size_t off = (size_t)row * DM + col0 + bj * HALF; const u32x4 xw = xin[mm][bj];
                    f32x4 x0 = (f32x4){bf_lo(xw.x), bf_hi(xw.x), bf_lo(xw.y), bf_hi(xw.y)}, x1 = (f32x4){bf_lo(xw.z), bf_hi(xw.z), bf_lo(xw.w), bf_hi(xw.w)};
                    const u32x4 pw = pin[mm][bj];
                    const f32x4 p0 = (f32x4){bf_lo(pw.x), bf_hi(pw.x), bf_lo(pw.y), bf_hi(pw.y)}, p1 = (f32x4){bf_lo(pw.z), bf_hi(pw.z), bf_lo(pw.w), bf_hi(pw.w)};
                    const i32x4 i0 = __builtin_bit_cast(i32x4, acc[ai][bj][m][0]), i1 = __builtin_bit_cast(i32x4, acc[ai][bj][m][1]);
                    const f32x4 a0 = (f32x4){(float)i0[0], (float)i0[1], (float)i0[2], (float)i0[3]} * (cw[bj][0] * rs), a1 = (f32x4){(float)i1[0], (float)i1[1], (float)i1[2], (float)i1[3]} * (cw[bj][1] * rs);
                    const f32x4 s0 = (f32x4){sigm1(a0[0]), sigm1(a0[1]), sigm1(a0[2]), sigm1(a0[3])}, s1 = (f32x4){sigm1(a1[0]), sigm1(a1[1]), sigm1(a1[2]), sigm1(a1[3])};
                    x0 = x0 + p0 * rp * g[bj][0] * s0; x1 = x1 + p1 * rp * g[bj][1] * s1;
                    if (l == DEPTH - 1) { *(f32x4*)(OUT + off) = x0; *(f32x4*)(OUT + off + 4) = x1; }
                    else *(u32x4*)(XD + off) = pack8(x0, x1); }
            } }
    }
};
}
namespace att {
typedef short bf16x8 __attribute__((ext_vector_type(8)));
typedef short s16x4 __attribute__((ext_vector_type(4)));
typedef float f32x16 __attribute__((ext_vector_type(16)));
typedef float f32x4 __attribute__((ext_vector_type(4)));
typedef unsigned u32x4 __attribute__((ext_vector_type(4)));
typedef int i32x4 __attribute__((ext_vector_type(4)));
typedef __attribute__((address_space(3))) char* lptr;
#define ATT_LAS __attribute__((address_space(3)))
#define ATT_SBAR() __builtin_amdgcn_sched_barrier(0)
constexpr int KROW_MLA = 400, KT_MLA = 64 * KROW_MLA, VT_MLA = 64 * 128 * 2;
constexpr int KROW_SWA = 144, KT_SWA = 64 * KROW_SWA, VT_SWA = 64 * 64 * 2;
constexpr int MLA_K = 0, MLA_V = 2 * KT_MLA;
constexpr int SWA_K = 0, SWA_V = 4 * KT_SWA, SWA_POS = SWA_V + 4 * VT_SWA;
constexpr int LDS_SCR = 90112;
constexpr int ATT_LDS_BYTES = LDS_SCR + 8 * 64 * 4;

__device__ __forceinline__ int crow(int r, int hi) { return (r & 3) + 8 * (r >> 2) + 4 * hi; }
__device__ __forceinline__ unsigned cvtpk(float lo, float hi) { return pg8::cvt_pk_bf16(lo, hi); }
template <int NCB> __device__ __forceinline__ int v_st(int k, int c) { const int kk = (k & ~0xC) | ((k & 4) << 1) | ((k & 8) >> 1); return ((kk >> 3) * NCB + (c >> 5)) * 512 + ((kk & 7) * 32 + (c & 31)) * 2; }
__device__ __forceinline__ int v_rd_base(int lane) { return ((lane & 3) << 3) | (((lane >> 2) & 3) << 6) | (((lane >> 4) & 1) << 5) | (((lane >> 5) & 1) << 8); }

__device__ __forceinline__ void mask_tile(f32x16& p0, f32x16& p1, int dq, unsigned W) {
    const float NEG = -__builtin_inff();
#pragma unroll
    for (int r = 0; r < 16; ++r) { const int c = (r & 3) + 8 * (r >> 2);
        if ((unsigned)(dq - c) >= W) p0[r] = NEG;
        if ((unsigned)(dq - c - 32) >= W) p1[r] = NEG; }
}
template <int ND0, int KROW> __device__ __forceinline__ void qkt(f32x16& p0, f32x16& p1, lptr kt, int r32, int hi, const bf16x8* qr) {
    p0 = f32x16{}; p1 = f32x16{};
    const lptr a = kt + r32 * KROW + hi * 16;
#pragma unroll
    for (int d0 = 0; d0 < ND0; ++d0) {
        const bf16x8 b0 = *(const ATT_LAS bf16x8*)(a + d0 * 32);
        const bf16x8 b1 = *(const ATT_LAS bf16x8*)(a + 32 * KROW + d0 * 32);
        p0 = __builtin_amdgcn_mfma_f32_32x32x16_bf16(b0, qr[d0], p0, 0, 0, 0);
        p1 = __builtin_amdgcn_mfma_f32_32x32x16_bf16(b1, qr[d0], p1, 0, 0, 0); }
}
template <int THR> __device__ __forceinline__ void softmax_tile(f32x16& p0, f32x16& p1, float& m_reg, float& l_reg, float& alpha, bf16x8& pa0, bf16x8& pa1, bf16x8& pa2, bf16x8& pa3) {
    float pmax = p0[0];
#pragma unroll
    for (int r = 1; r < 16; ++r) pmax = fmaxf(pmax, p0[r]);
#pragma unroll
    for (int r = 0; r < 16; ++r) pmax = fmaxf(pmax, p1[r]);
    { auto rr = __builtin_amdgcn_permlane32_swap(__float_as_uint(pmax), __float_as_uint(pmax), false, false); pmax = fmaxf(__uint_as_float(rr[0]), __uint_as_float(rr[1])); }
    float mn;
    if (THR > 0 && __all(pmax - m_reg <= (float)THR)) { mn = m_reg; alpha = 1.f; }
    else { mn = fmaxf(m_reg, pmax); alpha = __builtin_amdgcn_exp2f(m_reg - mn); m_reg = mn; }
    float ps = 0.f;
#pragma unroll
    for (int r = 0; r < 16; ++r) { p0[r] = __builtin_amdgcn_exp2f(p0[r] - mn); ps += p0[r]; }
#pragma unroll
    for (int r = 0; r < 16; ++r) { p1[r] = __builtin_amdgcn_exp2f(p1[r] - mn); ps += p1[r]; }
    { auto rr = __builtin_amdgcn_permlane32_swap(__float_as_uint(ps), __float_as_uint(ps), false, false); ps = __uint_as_float(rr[0]) + __uint_as_float(rr[1]); }
    l_reg = l_reg * alpha + ps;
#define ATT_PK4(P, B_, OUT) do { unsigned a0 = cvtpk(P[B_+0], P[B_+1]), a1 = cvtpk(P[B_+2], P[B_+3]); unsigned b0 = cvtpk(P[B_+4], P[B_+5]), b1 = cvtpk(P[B_+6], P[B_+7]); \
        auto r0 = __builtin_amdgcn_permlane32_swap(a0, b0, false, false); auto r1 = __builtin_amdgcn_permlane32_swap(a1, b1, false, false); \
        u32x4 w = {r0[0], r1[0], r0[1], r1[1]}; OUT = __builtin_bit_cast(bf16x8, w); } while (0)
    ATT_PK4(p0, 0, pa0); ATT_PK4(p0, 8, pa1); ATT_PK4(p1, 0, pa2); ATT_PK4(p1, 8, pa3);
#undef ATT_PK4
}
template <int THR> __device__ __forceinline__ void partial_sm(f32x16& p0, f32x16& p1, float& m_reg, float& alpha) {
    float pmax = p0[0];
#pragma unroll
    for (int r = 1; r < 16; ++r) pmax = fmaxf(pmax, p0[r]);
#pragma unroll
    for (int r = 0; r < 16; ++r) pmax = fmaxf(pmax, p1[r]);
    { auto rr = __builtin_amdgcn_permlane32_swap(__float_as_uint(pmax), __float_as_uint(pmax), false, false); pmax = fmaxf(__uint_as_float(rr[0]), __uint_as_float(rr[1])); }
    float mn;
    if (THR > 0 && __all(pmax - m_reg <= (float)THR)) { mn = m_reg; alpha = 1.f; }
    else { mn = fmaxf(m_reg, pmax); alpha = __builtin_amdgcn_exp2f(m_reg - mn); m_reg = mn; }
#pragma unroll
    for (int r = 0; r < 16; ++r) { p0[r] = __builtin_amdgcn_exp2f(p0[r] - mn); p1[r] = p1[r] - mn; }
}
__device__ __forceinline__ void finish_sm(f32x16& p0, f32x16& p1, float alpha, float& l_reg, bf16x8& pa0, bf16x8& pa1, bf16x8& pa2, bf16x8& pa3) {
    float ps = 0.f;
#pragma unroll
    for (int r = 0; r < 16; ++r) { p1[r] = __builtin_amdgcn_exp2f(p1[r]); ps += p0[r]; }
#pragma unroll
    for (int r = 0; r < 16; ++r) ps += p1[r];
    { auto rr = __builtin_amdgcn_permlane32_swap(__float_as_uint(ps), __float_as_uint(ps), false, false); ps = __uint_as_float(rr[0]) + __uint_as_float(rr[1]); }
    l_reg = l_reg * alpha + ps;
#define ATT_PK4(P, B_, OUT) do { unsigned a0 = cvtpk(P[B_+0], P[B_+1]), a1 = cvtpk(P[B_+2], P[B_+3]); unsigned b0 = cvtpk(P[B_+4], P[B_+5]), b1 = cvtpk(P[B_+6], P[B_+7]); \
        auto r0 = __builtin_amdgcn_permlane32_swap(a0, b0, false, false); auto r1 = __builtin_amdgcn_permlane32_swap(a1, b1, false, false); \
        u32x4 w = {r0[0], r1[0], r0[1], r1[1]}; OUT = __builtin_bit_cast(bf16x8, w); } while (0)
    ATT_PK4(p0, 0, pa0); ATT_PK4(p0, 8, pa1); ATT_PK4(p1, 0, pa2); ATT_PK4(p1, 8, pa3);
#undef ATT_PK4
}
#define ATT_TRRD(dst, off) asm volatile("ds_read_b64_tr_b16 %0, %1 offset:%2" : "=&v"(dst) : "v"(vb), "i"(off) : "memory")
#define ATT_PV_D0(NCB, d0) do { s16x4 l0, l1, l2, l3, h0, h1, h2, h3; constexpr int b_ = (d0) * 512, ks_ = (NCB) * 1024, hf_ = (NCB) * 512; \
        ATT_TRRD(l0, b_); ATT_TRRD(h0, b_ + hf_); ATT_TRRD(l1, b_ + ks_); ATT_TRRD(h1, b_ + ks_ + hf_); ATT_TRRD(l2, b_ + 2 * ks_); ATT_TRRD(h2, b_ + 2 * ks_ + hf_); ATT_TRRD(l3, b_ + 3 * ks_); ATT_TRRD(h3, b_ + 3 * ks_ + hf_); \
        asm volatile("s_waitcnt lgkmcnt(0)" ::: "memory"); ATT_SBAR(); \
        o[d0] = __builtin_amdgcn_mfma_f32_32x32x16_bf16(pa0, (bf16x8){l0[0], l0[1], l0[2], l0[3], h0[0], h0[1], h0[2], h0[3]}, o[d0], 0, 0, 0); \
        o[d0] = __builtin_amdgcn_mfma_f32_32x32x16_bf16(pa1, (bf16x8){l1[0], l1[1], l1[2], l1[3], h1[0], h1[1], h1[2], h1[3]}, o[d0], 0, 0, 0); \
        o[d0] = __builtin_amdgcn_mfma_f32_32x32x16_bf16(pa2, (bf16x8){l2[0], l2[1], l2[2], l2[3], h2[0], h2[1], h2[2], h2[3]}, o[d0], 0, 0, 0); \
        o[d0] = __builtin_amdgcn_mfma_f32_32x32x16_bf16(pa3, (bf16x8){l3[0], l3[1], l3[2], l3[3], h3[0], h3[1], h3[2], h3[3]}, o[d0], 0, 0, 0); } while (0)
__device__ __forceinline__ void pv4(f32x16* o, int vb, bf16x8 pa0, bf16x8 pa1, bf16x8 pa2, bf16x8 pa3) { ATT_PV_D0(4, 0); ATT_PV_D0(4, 1); ATT_PV_D0(4, 2); ATT_PV_D0(4, 3); }
__device__ __forceinline__ void pv2(f32x16* o, int vb, bf16x8 pa0, bf16x8 pa1, bf16x8 pa2, bf16x8 pa3) { ATT_PV_D0(2, 0); ATT_PV_D0(2, 1); }
#define ATT_RESC(ND, a) do { if (__any((a) < 1.f)) { if (hi == 0) al_l[r32] = (a); asm volatile("s_waitcnt lgkmcnt(0)" ::: "memory"); \
        _Pragma("unroll") for (int d_ = 0; d_ < ND; ++d_) _Pragma("unroll") for (int r = 0; r < 16; ++r) o[d_][r] *= al_l[crow(r, hi)]; } } while (0)

__device__ __forceinline__ void mla_unit(int b, int h, int qb, const short* __restrict__ QBp, const short* __restrict__ KBp, const short* __restrict__ VBp, const float* __restrict__ ropec, const float* __restrict__ ropes, short* Op, lptr lds, int wv) {
    int tid_ = TIDX(wv);
    const int tid = tid_, wid = wv, lane = tid & 63, r32 = lane & 31, hi = lane >> 5;
    const size_t rowbase = (size_t)b * SEQ; const int q0 = qb * 256;
    bf16x8 qr[12];
    { const short* qp = QBp + (rowbase + q0 + wid * 32 + r32) * QB_PITCH + h * 192 + hi * 8;
#pragma unroll
      for (int d0 = 0; d0 < 12; ++d0) qr[d0] = *(const bf16x8*)(qp + d0 * 16); }
    f32x4 rc[2][2], rsn[2][2];
    { const size_t ro = (rowbase + q0 + wid * 32 + r32) * 32 + hi * 8;
#pragma unroll
      for (int dd = 0; dd < 2; ++dd) { rc[dd][0] = *(const f32x4*)(ropec + ro + dd * 16); rc[dd][1] = *(const f32x4*)(ropec + ro + dd * 16 + 4); rsn[dd][0] = *(const f32x4*)(ropes + ro + dd * 16); rsn[dd][1] = *(const f32x4*)(ropes + ro + dd * 16 + 4); } }
    const short* Kg = KBp + rowbase * KB_PITCH + h * 192; const short* Vg = VBp + rowbase * VB_PITCH + h * 128;
    const int NT = 4 * (qb + 1);
    const int srow = tid >> 3, sch = tid & 7;
    const int kgo = srow * KB_PITCH + sch * 8, klo = srow * KROW_MLA + sch * 16, vgo = srow * VB_PITCH + sch * 8, vlo = v_st<4>(srow, sch * 8);
    bf16x8 sk[3], sv[2];
#define MLA_LOADT(t) do { const short* kp_ = Kg + (size_t)(t) * 64 * KB_PITCH + kgo; const short* vp_ = Vg + (size_t)(t) * 64 * VB_PITCH + vgo; \
        _Pragma("unroll") for (int i = 0; i < 3; ++i) sk[i] = *(const bf16x8*)(kp_ + 64 * i); _Pragma("unroll") for (int i = 0; i < 2; ++i) sv[i] = *(const bf16x8*)(vp_ + 64 * i); } while (0)
#define MLA_WRITET(bf) do { _Pragma("unroll") for (int i = 0; i < 3; ++i) *(ATT_LAS bf16x8*)(lds + MLA_K + (bf) * KT_MLA + klo + 128 * i) = sk[i]; \
        _Pragma("unroll") for (int i = 0; i < 2; ++i) *(ATT_LAS bf16x8*)(lds + MLA_V + (bf) * VT_MLA + vlo + 1024 * i) = sv[i]; } while (0)
    MLA_LOADT(0);
#pragma unroll
    for (int dd = 0; dd < 2; ++dd) { const f32x4 c0 = rc[dd][0], c1 = rc[dd][1], s0 = rsn[dd][0], s1 = rsn[dd][1];
        const u32x4 w1 = __builtin_bit_cast(u32x4, qr[8 + dd]), w2 = __builtin_bit_cast(u32x4, qr[10 + dd]); u32x4 o1, o2;
#pragma unroll
        for (int e = 0; e < 4; ++e) { const float ca = e < 2 ? c0[2 * e] : c1[2 * e - 4], cb = e < 2 ? c0[2 * e + 1] : c1[2 * e - 3], sa = e < 2 ? s0[2 * e] : s1[2 * e - 4], sb = e < 2 ? s0[2 * e + 1] : s1[2 * e - 3];
            const float x1a = __uint_as_float(w1[e] << 16), x1b = __uint_as_float(w1[e] & 0xffff0000u), x2a = __uint_as_float(w2[e] << 16), x2b = __uint_as_float(w2[e] & 0xffff0000u);
            o1[e] = cvtpk(x1a * ca - x2a * sa, x1b * cb - x2b * sb); o2[e] = cvtpk(x2a * ca + x1a * sa, x2b * cb + x1b * sb); }
        qr[8 + dd] = __builtin_bit_cast(bf16x8, o1); qr[10 + dd] = __builtin_bit_cast(bf16x8, o2); }
    MLA_WRITET(0); __syncthreads();
    float m_reg = -1e30f, l_reg = 0.f; f32x16 o[4] = {};
    ATT_LAS float* al_l = (ATT_LAS float*)(lds + LDS_SCR) + wid * 64; ATT_LAS float* li_l = al_l + 32;
    const int vb0 = (int)(unsigned)(size_t)(lds + MLA_V) + v_rd_base(lane);
    const int qlo = q0 + wid * 32, qpos = qlo + r32;
    f32x16 pA0, pA1, pB0, pB1; float alA, alB; bf16x8 pa0, pa1, pa2, pa3;
#define MLA_SCORE(P0, P1, t_, bf_) qkt<12, KROW_MLA>(P0, P1, lds + MLA_K + (bf_) * KT_MLA, r32, hi, qr)
#define MLA_MASK(P0, P1, t_) do { if ((t_) * 64 + 63 > qlo) { asm volatile("" ::: "memory"); mask_tile(P0, P1, qpos - (t_) * 64 - 4 * hi, 0x7fffffffu); } } while (0)
    MLA_SCORE(pA0, pA1, 0, 0); MLA_MASK(pA0, pA1, 0); partial_sm<8>(pA0, pA1, m_reg, alA);
    MLA_LOADT(1); MLA_WRITET(1); __syncthreads();
    for (int j = 1; j + 1 < NT; j += 2) {
        ATT_SBAR(); MLA_SCORE(pB0, pB1, j, 1);
        finish_sm(pA0, pA1, alA, l_reg, pa0, pa1, pa2, pa3); ATT_SBAR();
        MLA_MASK(pB0, pB1, j); MLA_LOADT(j + 1); ATT_SBAR();
        pv4(o, vb0, pa0, pa1, pa2, pa3); partial_sm<8>(pB0, pB1, m_reg, alB);
        __syncthreads(); MLA_WRITET(0);
        ATT_RESC(4, alB); __syncthreads();
        ATT_SBAR(); MLA_SCORE(pA0, pA1, j + 1, 0);
        finish_sm(pB0, pB1, alB, l_reg, pa0, pa1, pa2, pa3); ATT_SBAR();
        MLA_MASK(pA0, pA1, j + 1); MLA_LOADT(j + 2); ATT_SBAR();
        pv4(o, vb0 + VT_MLA, pa0, pa1, pa2, pa3); partial_sm<8>(pA0, pA1, m_reg, alA);
        __syncthreads(); MLA_WRITET(1);
        ATT_RESC(4, alA); __syncthreads();
    }
    ATT_SBAR(); MLA_SCORE(pB0, pB1, NT - 1, 1);
    finish_sm(pA0, pA1, alA, l_reg, pa0, pa1, pa2, pa3); ATT_SBAR();
    MLA_MASK(pB0, pB1, NT - 1);
    pv4(o, vb0, pa0, pa1, pa2, pa3); partial_sm<8>(pB0, pB1, m_reg, alB);
    ATT_RESC(4, alB);
    finish_sm(pB0, pB1, alB, l_reg, pa0, pa1, pa2, pa3); ATT_SBAR();
    pv4(o, vb0 + VT_MLA, pa0, pa1, pa2, pa3);
    __syncthreads();
#undef MLA_SCORE
#undef MLA_MASK
#undef MLA_LOADT
#undef MLA_WRITET
    if (hi == 0) li_l[r32] = l_reg; asm volatile("s_waitcnt lgkmcnt(0)" ::: "memory");
    float rli[16];
#pragma unroll
    for (int r = 0; r < 16; ++r) rli[r] = __builtin_amdgcn_rcpf(li_l[crow(r, hi)]);
    short* Ow = Op + (rowbase + q0 + wid * 32) * 2048 + 1024 + h * 128;
#pragma unroll
    for (int r = 0; r < 16; ++r) { const int orow = crow(r, hi);
#pragma unroll
        for (int d0 = 0; d0 < 4; ++d0) { const float v = o[d0][r] * rli[r]; const float vn = __shfl_xor(v, 1);
            if ((r32 & 1) == 0) *(unsigned*)(Ow + (size_t)orow * 2048 + d0 * 32 + r32) = cvtpk(v, vn); } }
}
__device__ __forceinline__ void swa_unit(int b, int kvh, int n, const short* __restrict__ QAp, const short* __restrict__ KAp, const short* __restrict__ VAp, const int* __restrict__ pos, const float* __restrict__ sinks, short* Op, lptr lds, int wv) {
    int tid_ = TIDX(wv);
    const int tid = tid_, wid = wv, lane = tid & 63, r32 = lane & 31, hi = lane >> 5;
    const size_t rowbase = (size_t)b * SEQ; const int key0 = 128 * (n - 1);
    ATT_LAS int* posl = (ATT_LAS int*)(lds + SWA_POS);
    const int rho = wid & 3, hqA = 4 * kvh + (wid >> 2), hqB = hqA + 2, qrow0 = 128 * n + 32 * rho;
    bf16x8 qrA[4], qrB[4];
    { const short* qp = QAp + (rowbase + qrow0 + r32) * QA_PITCH + hi * 8;
#pragma unroll
      for (int d0 = 0; d0 < 4; ++d0) { qrA[d0] = *(const bf16x8*)(qp + hqA * 64 + d0 * 16); qrB[d0] = *(const bf16x8*)(qp + hqB * 64 + d0 * 16); } }
    const int pq = pos[rowbase + qrow0 + r32];
    const float sinkA = sinks[hqA], sinkB = sinks[hqB];
#pragma unroll
    for (int i = 0; i < 4; ++i) { const int c = tid + 512 * i, row = c >> 3, ch = c & 7;
        if (key0 + row >= 0) {
            const bf16x8 kk = *(const bf16x8*)(KAp + (rowbase + key0 + row) * KA_PITCH + kvh * 64 + ch * 8);
            const bf16x8 vv = *(const bf16x8*)(VAp + (rowbase + key0 + row) * VA_PITCH + kvh * 64 + ch * 8);
            *(ATT_LAS bf16x8*)(lds + SWA_K + row * KROW_SWA + ch * 16) = kk;
            *(ATT_LAS bf16x8*)(lds + SWA_V + (row >> 6) * VT_SWA + v_st<2>(row & 63, ch * 8)) = vv; } }
    if (tid < 256 && key0 + tid >= 0) posl[tid] = pos[rowbase + key0 + tid];
    __syncthreads();
    ATT_LAS float* al_l = (ATT_LAS float*)(lds + LDS_SCR) + wid * 64; ATT_LAS float* li_l = al_l + 32;
    const int vb0 = (int)(unsigned)(size_t)(lds + SWA_V) + v_rd_base(lane);
    const float slopeA = __builtin_amdgcn_exp2f(-0.5f * (float)(hqA + 1)) * LOG2E, slopeB = __builtin_amdgcn_exp2f(-0.5f * (float)(hqB + 1)) * LOG2E;
    float one_ = 1.0f; asm volatile("" : "+v"(one_));
    float mA = sinkA * LOG2E, lA = one_, mB = sinkB * LOG2E, lB = one_; f32x16 oA[2] = {}, oB[2] = {};
#define SWA_RESC(O, a) do { if (__any((a) < 1.f)) { if (hi == 0) al_l[r32] = (a); asm volatile("s_waitcnt lgkmcnt(0)" ::: "memory"); \
        _Pragma("unroll") for (int d_ = 0; d_ < 2; ++d_) _Pragma("unroll") for (int r = 0; r < 16; ++r) O[d_][r] *= al_l[crow(r, hi)]; asm volatile("s_waitcnt lgkmcnt(0)" ::: "memory"); } } while (0)
    for (int j = 0; j < 3; ++j) { const int lt = (rho >> 1) + j;
        if (n == 0 && lt < 2) continue;
        f32x16 pA0 = {}, pA1 = {}, pB0 = {}, pB1 = {};
        { const lptr a = lds + SWA_K + lt * KT_SWA + r32 * KROW_SWA + hi * 16;
#pragma unroll
          for (int d0 = 0; d0 < 4; ++d0) { const bf16x8 b0 = *(const ATT_LAS bf16x8*)(a + d0 * 32), b1 = *(const ATT_LAS bf16x8*)(a + 32 * KROW_SWA + d0 * 32);
              pA0 = __builtin_amdgcn_mfma_f32_32x32x16_bf16(b0, qrA[d0], pA0, 0, 0, 0); pB0 = __builtin_amdgcn_mfma_f32_32x32x16_bf16(b0, qrB[d0], pB0, 0, 0, 0);
              pA1 = __builtin_amdgcn_mfma_f32_32x32x16_bf16(b1, qrA[d0], pA1, 0, 0, 0); pB1 = __builtin_amdgcn_mfma_f32_32x32x16_bf16(b1, qrB[d0], pB1, 0, 0, 0); } }
#pragma unroll
        for (int g4 = 0; g4 < 4; ++g4) { const i32x4 k0 = *(const ATT_LAS i32x4*)(posl + lt * 64 + 8 * g4 + 4 * hi), k1 = *(const ATT_LAS i32x4*)(posl + lt * 64 + 32 + 8 * g4 + 4 * hi);
#pragma unroll
            for (int e = 0; e < 4; ++e) { int d0_ = pq - k0[e], d1_ = pq - k1[e]; d0_ = d0_ < 0 ? -d0_ : d0_; d1_ = d1_ < 0 ? -d1_ : d1_; const float f0 = (float)d0_, f1 = (float)d1_;
                pA0[4 * g4 + e] -= slopeA * f0; pA1[4 * g4 + e] -= slopeA * f1; pB0[4 * g4 + e] -= slopeB * f0; pB1[4 * g4 + e] -= slopeB * f1; } }
        { const int dq = (qrow0 + r32) - (key0 + 64 * lt) - 4 * hi; mask_tile(pA0, pA1, dq, 128u); mask_tile(pB0, pB1, dq, 128u); }
        float alA, alB; bf16x8 a0, a1, a2, a3, b0_, b1_, b2_, b3_;
        softmax_tile<8>(pA0, pA1, mA, lA, alA, a0, a1, a2, a3);
        softmax_tile<8>(pB0, pB1, mB, lB, alB, b0_, b1_, b2_, b3_);
        SWA_RESC(oA, alA); SWA_RESC(oB, alB);
        { const int vb = vb0 + lt * VT_SWA;
#define SWA_PV2(d0) do { s16x4 l0, l1, l2, l3, h0, h1, h2, h3; constexpr int b_ = (d0) * 512, ks_ = 2 * 1024, hf_ = 2 * 512; \
          ATT_TRRD(l0, b_); ATT_TRRD(h0, b_ + hf_); ATT_TRRD(l1, b_ + ks_); ATT_TRRD(h1, b_ + ks_ + hf_); ATT_TRRD(l2, b_ + 2 * ks_); ATT_TRRD(h2, b_ + 2 * ks_ + hf_); ATT_TRRD(l3, b_ + 3 * ks_); ATT_TRRD(h3, b_ + 3 * ks_ + hf_); \
          asm volatile("s_waitcnt lgkmcnt(0)" ::: "memory"); ATT_SBAR(); \
          const bf16x8 v0_ = (bf16x8){l0[0], l0[1], l0[2], l0[3], h0[0], h0[1], h0[2], h0[3]}, v1_ = (bf16x8){l1[0], l1[1], l1[2], l1[3], h1[0], h1[1], h1[2], h1[3]}; \
          const bf16x8 v2_ = (bf16x8){l2[0], l2[1], l2[2], l2[3], h2[0], h2[1], h2[2], h2[3]}, v3_ = (bf16x8){l3[0], l3[1], l3[2], l3[3], h3[0], h3[1], h3[2], h3[3]}; \
          oA[d0] = __builtin_amdgcn_mfma_f32_32x32x16_bf16(a0, v0_, oA[d0], 0, 0, 0); oB[d0] = __builtin_amdgcn_mfma_f32_32x32x16_bf16(b0_, v0_, oB[d0], 0, 0, 0); \
          oA[d0] = __builtin_amdgcn_mfma_f32_32x32x16_bf16(a1, v1_, oA[d0], 0, 0, 0); oB[d0] = __builtin_amdgcn_mfma_f32_32x32x16_bf16(b1_, v1_, oB[d0], 0, 0, 0); \
          oA[d0] = __builtin_amdgcn_mfma_f32_32x32x16_bf16(a2, v2_, oA[d0], 0, 0, 0); oB[d0] = __builtin_amdgcn_mfma_f32_32x32x16_bf16(b2_, v2_, oB[d0], 0, 0, 0); \
          oA[d0] = __builtin_amdgcn_mfma_f32_32x32x16_bf16(a3, v3_, oA[d0], 0, 0, 0); oB[d0] = __builtin_amdgcn_mfma_f32_32x32x16_bf16(b3_, v3_, oB[d0], 0, 0, 0); } while (0)
          SWA_PV2(0); SWA_PV2(1);
#undef SWA_PV2
        }
    }
#undef SWA_RESC
#define SWA_EPI(O, L, HQ) do { if (hi == 0) li_l[r32] = (L); asm volatile("s_waitcnt lgkmcnt(0)" ::: "memory"); float rli[16]; \
        _Pragma("unroll") for (int r = 0; r < 16; ++r) rli[r] = __builtin_amdgcn_rcpf(li_l[crow(r, hi)]); asm volatile("s_waitcnt lgkmcnt(0)" ::: "memory"); \
        short* Ow = Op + (rowbase + qrow0) * 2048 + (HQ) * 64; \
        _Pragma("unroll") for (int r = 0; r < 16; ++r) { const int orow = crow(r, hi); \
            _Pragma("unroll") for (int d0 = 0; d0 < 2; ++d0) { const float v = O[d0][r] * rli[r]; const float vn = __shfl_xor(v, 1); \
                if ((r32 & 1) == 0) *(unsigned*)(Ow + (size_t)orow * 2048 + d0 * 32 + r32) = cvtpk(v, vn); } } } while (0)
    SWA_EPI(oA, lA, hqA); SWA_EPI(oB, lB, hqB);
#undef SWA_EPI
    __syncthreads();
}
#undef ATT_RESC
}
constexpr int NWAVES = 8;
#ifndef PROBE_DUP_P0
#define PROBE_DUP_P0 1
#endif
#ifndef PROBE_DUP_ATT
#define PROBE_DUP_ATT 1
#endif
constexpr int CW_BAR = 4096;
constexpr int RING_BYTES = 131072, EPI_T_OFF = RING_BYTES, MISC_OFF = RING_BYTES + 4096, RS_OFF = MISC_OFF + 1024, CS_OFF = RS_OFF + 2048, CS_UNITS = 12, LDS_BYTES = 151552;
static_assert(att::ATT_LDS_BYTES <= RING_BYTES, "attention scratch fits the ring region");
static_assert(CS_OFF + CS_UNITS * 1024 <= LDS_BYTES, "LDS tables fit");

#define GAS __attribute__((address_space(1)))
#define LAS __attribute__((address_space(3)))
typedef unsigned short bf16;
typedef unsigned v4u __attribute__((ext_vector_type(4)));
typedef float f32x4 __attribute__((ext_vector_type(4)));
typedef short bf16x8 __attribute__((ext_vector_type(8)));
typedef GAS unsigned gu32;
typedef GAS unsigned long long gu64;
#define RLX_AGENT __ATOMIC_RELAXED, __HIP_MEMORY_SCOPE_AGENT
#define LDS_WAIT() asm volatile("s_waitcnt lgkmcnt(0)" ::: "memory")
#define VM_WAIT() asm volatile("s_waitcnt vmcnt(0)" ::: "memory")
__device__ __forceinline__ unsigned long long rt() { return __builtin_amdgcn_s_memrealtime(); }
__device__ __forceinline__ unsigned f2bf(float f) { unsigned u = __builtin_bit_cast(unsigned, f); return (u + 0x7fffu + ((u >> 16) & 1u)) >> 16; }
__device__ __forceinline__ unsigned pk2(float lo, float hi) { return f2bf(lo) | (f2bf(hi) << 16); }

#define XB_TMO      128
#define XB_XCNT(j)  (256  + 64 * (j))
#define XB_XSUB(j)  (1280 + 64 * (j))
#define XB_XGEN(j)  (2304 + 64 * (j))
#define XB_TOP      3328
#define XB_TOPGEN   3392
#define XCD_BAR_WORDS 3456
#define XB_SPIN_CAP (1u << 18)

__device__ __forceinline__ unsigned xb_ld(unsigned* p)              { return __hip_atomic_load(p, __ATOMIC_RELAXED, __HIP_MEMORY_SCOPE_AGENT); }
__device__ __forceinline__ unsigned xb_add(unsigned* p, unsigned v) { return __hip_atomic_fetch_add(p, v, __ATOMIC_RELAXED, __HIP_MEMORY_SCOPE_AGENT); }
__device__ __forceinline__ unsigned xb_xcc_id() { return (unsigned)__builtin_amdgcn_s_getreg((3 << 11) | 20) & 0xFu; }
#define XB_SPIN(cond, bar) do { unsigned _sp = 0; while (cond) { __builtin_amdgcn_s_sleep(1); \
    if ((++_sp & 255u) == 0u) { if (xb_ld(&(bar)[XB_TMO])) break; if (_sp > XB_SPIN_CAP) { atomicAdd(&(bar)[XB_TMO], 1u); break; } } } } while (0)

struct XcdBarrier {
    unsigned* bar; unsigned x;
    volatile LAS unsigned* st;
};

__device__ __forceinline__ XcdBarrier xcd_barrier_post(unsigned* bar, volatile LAS unsigned* st, int wv) {
    XcdBarrier b; b.bar = bar; b.x = xb_xcc_id(); b.st = st;
    if (TIDX(wv) == 0) (void)xb_add(&bar[XB_XCNT(b.x)], 1u);
    return b;
}
__device__ __forceinline__ void xcd_barrier_complete(unsigned* bar, unsigned x, unsigned& nloc, unsigned& nx) {
    const unsigned G = gridDim.x * gridDim.y * gridDim.z;
    unsigned sum, cnt, mine, sp = 0u;
    for (;;) {
        sum = 0u; cnt = 0u; mine = 0u;
#pragma unroll
        for (unsigned j = 0; j < 16; ++j) { const unsigned c = xb_ld(&bar[XB_XCNT(j)]); sum += c; cnt += (c > 0u) ? 1u : 0u; mine = (j == x) ? c : mine; }
        if (sum == G) break;
        __builtin_amdgcn_s_sleep(1);
        if ((++sp & 255u) == 0u) { if (xb_ld(&bar[XB_TMO])) break; if (sp > XB_SPIN_CAP) { atomicAdd(&bar[XB_TMO], 1u); break; } }
    }
    nloc = mine > 0u ? mine : 1u; nx = cnt > 0u ? cnt : 1u;
}

__device__ __forceinline__ void xcd_barrier(const XcdBarrier& b, int wv) {
    asm volatile("s_waitcnt vmcnt(0)" ::: "memory");
    __syncthreads();
    if (TIDX(wv) == 0) {
        unsigned* bar = b.bar; unsigned bxcc = b.x; asm volatile("" : "+s"(bar), "+s"(bxcc));
        __builtin_amdgcn_s_waitcnt(0);
        unsigned nloc = b.st[0], nx = b.st[1];
        if (nloc == 0u) { xcd_barrier_complete(bar, bxcc, nloc, nx); b.st[0] = nloc; b.st[1] = nx; }
        const unsigned old = xb_add(&bar[XB_XSUB(bxcc)], 1u);
        const unsigned gen = old / nloc;
        if (old + 1u == (gen + 1u) * nloc) {
            __builtin_amdgcn_fence(__ATOMIC_RELEASE, "agent");
            asm volatile("s_waitcnt vmcnt(0)" ::: "memory");
            const unsigned og = xb_add(&bar[XB_TOP], 1u);
            const unsigned tg = og / nx;
            if (og + 1u == (tg + 1u) * nx) xb_add(&bar[XB_TOPGEN], 1u);
            else XB_SPIN(xb_ld(&bar[XB_TOPGEN]) == tg, bar);
            __builtin_amdgcn_fence(__ATOMIC_ACQUIRE, "agent");
            xb_add(&bar[XB_XGEN(bxcc)], 1u);
            asm volatile("s_waitcnt vmcnt(0)" ::: "memory");
        } else {
            XB_SPIN(xb_ld(&bar[XB_XGEN(bxcc)]) == gen, bar);
            __builtin_amdgcn_fence(__ATOMIC_ACQUIRE, "agent");
            asm volatile("s_waitcnt vmcnt(0)" ::: "memory");
        }
    }
    __syncthreads();
}

constexpr int CW_GXCC = 24576;
constexpr int CW_GRP = 16384;
__device__ __forceinline__ void group_barrier(unsigned* cnt, unsigned target, unsigned* tmo, int wv, bool same_xcd) {
    asm volatile("s_waitcnt vmcnt(0)" ::: "memory");
    __syncthreads();
    if (TIDX(wv) == 0) {
        if (same_xcd) __builtin_amdgcn_fence(__ATOMIC_RELEASE, "workgroup"); else __builtin_amdgcn_fence(__ATOMIC_RELEASE, "agent");
        asm volatile("s_waitcnt vmcnt(0)" ::: "memory");
        (void)xb_add(cnt, 1u);
        unsigned sp = 0u;
        while (xb_ld(cnt) < target) { __builtin_amdgcn_s_sleep(1); if ((++sp & 255u) == 0u) { if (xb_ld(tmo)) break; if (sp > XB_SPIN_CAP) { atomicAdd(tmo, 1u); break; } } }
        __builtin_amdgcn_fence(__ATOMIC_ACQUIRE, "agent");
        asm volatile("s_waitcnt vmcnt(0)" ::: "memory");
    }
    __syncthreads();
}
constexpr float I8_MAGIC = 12582912.0f;
typedef unsigned v2u __attribute__((ext_vector_type(2)));
__device__ __forceinline__ unsigned pack4_i8(float a, float b, float c, float d) {
    return __builtin_amdgcn_perm(__builtin_bit_cast(unsigned, b), __builtin_bit_cast(unsigned, a), 0x0c0c0400u) | __builtin_amdgcn_perm(__builtin_bit_cast(unsigned, d), __builtin_bit_cast(unsigned, c), 0x04000c0cu);
}
template <int RT = 4>
__device__ __forceinline__ void quant_panel(const bf16* __restrict__ X, signed char* __restrict__ Q8, float* __restrict__ rsg, LAS float* rst, int r0, int rbase, int ntrips, int lane) {
    for (int t = 0; t < ntrips; ++t) {
        const int rb = rbase + t * RT;
        v4u x[RT][4];
#pragma unroll
        for (int i = 0; i < RT; ++i)
#pragma unroll
            for (int j = 0; j < 4; ++j) x[i][j] = *(const v4u*)(X + (size_t)(rb + i) * DM + j * 512 + lane * 8);
#pragma unroll
        for (int i = 0; i < RT; ++i) { float am = 0.f, ss = 0.f;
#pragma unroll
            for (int j = 0; j < 4; ++j)
#pragma unroll
                for (int e = 0; e < 4; ++e) { const float lo = pg8::bf_lo(x[i][j][e]), hi = pg8::bf_hi(x[i][j][e]); am = fmaxf(am, fmaxf(fabsf(lo), fabsf(hi))); ss += lo * lo + hi * hi; }
#pragma unroll
            for (int o = 1; o < 64; o <<= 1) { am = fmaxf(am, __shfl_xor(am, o)); ss += __shfl_xor(ss, o); }
            am = fmaxf(am, 1e-30f); const float inv = 127.0f * __builtin_amdgcn_rcpf(am);
#pragma unroll
            for (int j = 0; j < 4; ++j) { float q[8];
#pragma unroll
                for (int e = 0; e < 4; ++e) { q[2 * e] = __builtin_fmaf(pg8::bf_lo(x[i][j][e]), inv, I8_MAGIC); q[2 * e + 1] = __builtin_fmaf(pg8::bf_hi(x[i][j][e]), inv, I8_MAGIC); }
                v2u o; o.x = pack4_i8(q[0], q[1], q[2], q[3]); o.y = pack4_i8(q[4], q[5], q[6], q[7]);
                *(v2u*)(Q8 + (size_t)(rb + i) * DM + j * 512 + lane * 8) = o; }
            if (lane == 0) { const float sc = pg8::rsq(ss * (1.0f / DM) + EPS) * am * (1.0f / 127.0f); rsg[rb + i] = sc; if (rst) rst[rb + i - r0] = sc; } }
    }
}
__device__ __forceinline__ void cvt_strip8(const float* __restrict__ W, int ldw, int c0, const float* __restrict__ gain, signed char* __restrict__ dst, int n0, float* __restrict__ wsc, LAS float* scr, LAS float* cmx, int wave, int lane) {
    const int c = lane & 7;
    f32x4 v[4][8]; f32x4 mx = (f32x4){0.f, 0.f, 0.f, 0.f};
#pragma unroll
    for (int it = 0; it < 4; ++it)
#pragma unroll
        for (int i = 0; i < 8; ++i) { const int kk = (wave * 4 + it) * 64 + 8 * i + (lane >> 3);
            v[it][i] = *(const f32x4*)(W + (size_t)kk * ldw + c0 + 4 * c) * gain[kk];
#pragma unroll
            for (int e = 0; e < 4; ++e) mx[e] = fmaxf(mx[e], fabsf(v[it][i][e])); }
#pragma unroll
    for (int o = 8; o < 64; o <<= 1)
#pragma unroll
        for (int e = 0; e < 4; ++e) mx[e] = fmaxf(mx[e], __shfl_xor(mx[e], o));
    if (lane < 8) *(LAS f32x4*)(cmx + wave * 32 + 4 * c) = mx;
    __syncthreads();
    f32x4 cm = *(const LAS f32x4*)(cmx + 4 * c);
#pragma unroll
    for (int w = 1; w < 8; ++w) { const f32x4 t = *(const LAS f32x4*)(cmx + w * 32 + 4 * c);
#pragma unroll
        for (int e = 0; e < 4; ++e) cm[e] = fmaxf(cm[e], t[e]); }
    f32x4 inv;
#pragma unroll
    for (int e = 0; e < 4; ++e) { cm[e] = fmaxf(cm[e], 1e-30f); inv[e] = 127.0f * __builtin_amdgcn_rcpf(cm[e]); }
    if (wave == 0 && lane < 8) *(f32x4*)(wsc + n0 + 4 * c) = cm * (1.0f / 127.0f);
#pragma unroll
    for (int it = 0; it < 4; ++it) { const int k0 = (wave * 4 + it) * 64;
#pragma unroll
        for (int i = 0; i < 8; ++i) { const int kk = 8 * i + (lane >> 3); LAS float* s = scr + kk * 33 + 4 * c;
#pragma unroll
            for (int e = 0; e < 4; ++e) s[e] = __builtin_fmaf(v[it][i][e], inv[e], I8_MAGIC); }
        LDS_WAIT(); asm volatile("" ::: "memory");
#pragma unroll
        for (int j = 0; j < 4; ++j) { const int n = (lane >> 3) + 8 * j; const LAS float* s = scr + (8 * c) * 33 + n;
            v2u o; o.x = pack4_i8(s[0 * 33], s[1 * 33], s[2 * 33], s[3 * 33]); o.y = pack4_i8(s[4 * 33], s[5 * 33], s[6 * 33], s[7 * 33]);
            *(v2u*)(dst + (size_t)(n0 + n) * DM + k0 + 8 * c) = o; }
        LDS_WAIT(); asm volatile("" ::: "memory"); }
    __syncthreads();
}
__device__ __forceinline__ void cvt_strip8_2p(const float* __restrict__ W, int ldw, int c0, int nkb, signed char* __restrict__ dst, int Kd, int n0, float* __restrict__ wsc, LAS float* scr, LAS float* cmx, int wave, int lane) {
    const int c = lane & 7;
    f32x4 mx = (f32x4){0.f, 0.f, 0.f, 0.f};
    for (int kb = wave; kb < nkb; kb += 8) {
#pragma unroll
        for (int i = 0; i < 8; ++i) { const int kk = kb * 64 + 8 * i + (lane >> 3); const f32x4 v = *(const f32x4*)(W + (size_t)kk * ldw + c0 + 4 * c);
#pragma unroll
            for (int e = 0; e < 4; ++e) mx[e] = fmaxf(mx[e], fabsf(v[e])); } }
#pragma unroll
    for (int o = 8; o < 64; o <<= 1)
#pragma unroll
        for (int e = 0; e < 4; ++e) mx[e] = fmaxf(mx[e], __shfl_xor(mx[e], o));
    if (lane < 8) *(LAS f32x4*)(cmx + wave * 32 + 4 * c) = mx;
    __syncthreads();
    f32x4 cm = *(const LAS f32x4*)(cmx + 4 * c);
#pragma unroll
    for (int w = 1; w < 8; ++w) { const f32x4 t = *(const LAS f32x4*)(cmx + w * 32 + 4 * c);
#pragma unroll
        for (int e = 0; e < 4; ++e) cm[e] = fmaxf(cm[e], t[e]); }
    f32x4 inv;
#pragma unroll
    for (int e = 0; e < 4; ++e) { cm[e] = fmaxf(cm[e], 1e-30f); inv[e] = 127.0f * __builtin_amdgcn_rcpf(cm[e]); }
    if (wave == 0 && lane < 8) *(f32x4*)(wsc + n0 + 4 * c) = cm * (1.0f / 127.0f);
    for (int kb = wave; kb < nkb; kb += 8) { const int k0 = kb * 64;
#pragma unroll
        for (int i = 0; i < 8; ++i) { const int kk = 8 * i + (lane >> 3); const f32x4 v = *(const f32x4*)(W + (size_t)(k0 + kk) * ldw + c0 + 4 * c); LAS float* s = scr + kk * 33 + 4 * c;
#pragma unroll
            for (int e = 0; e < 4; ++e) s[e] = __builtin_fmaf(v[e], inv[e], I8_MAGIC); }
        LDS_WAIT(); asm volatile("" ::: "memory");
#pragma unroll
        for (int j = 0; j < 4; ++j) { const int n = (lane >> 3) + 8 * j; const LAS float* s = scr + (8 * c) * 33 + n;
            v2u o; o.x = pack4_i8(s[0 * 33], s[1 * 33], s[2 * 33], s[3 * 33]); o.y = pack4_i8(s[4 * 33], s[5 * 33], s[6 * 33], s[7 * 33]);
            *(v2u*)(dst + (size_t)(n0 + n) * Kd + k0 + 8 * c) = o; }
        LDS_WAIT(); asm volatile("" ::: "memory"); }
    __syncthreads();
}
__device__ __forceinline__ void quant_rows_u(const bf16* __restrict__ U, signed char* __restrict__ Q, float* __restrict__ rsu, int m0, int m1, int ms, int lane) {
    for (int m = m0; m < m1; m += ms) {
        v4u x[2][11];
#pragma unroll
        for (int i = 0; i < 2; ++i)
#pragma unroll
            for (int j = 0; j < 11; ++j) x[i][j] = *(const v4u*)(U + (size_t)(m + i) * DFF + j * 512 + lane * 8);
#pragma unroll
        for (int i = 0; i < 2; ++i) { float am = 0.f;
#pragma unroll
            for (int j = 0; j < 11; ++j)
#pragma unroll
                for (int e = 0; e < 4; ++e) am = fmaxf(am, fmaxf(fabsf(pg8::bf_lo(x[i][j][e])), fabsf(pg8::bf_hi(x[i][j][e]))));
#pragma unroll
            for (int o = 1; o < 64; o <<= 1) am = fmaxf(am, __shfl_xor(am, o));
            am = fmaxf(am, 1e-30f); const float inv = 127.0f * __builtin_amdgcn_rcpf(am);
#pragma unroll
            for (int j = 0; j < 11; ++j) { float q[8];
#pragma unroll
                for (int e = 0; e < 4; ++e) { q[2 * e] = __builtin_fmaf(pg8::bf_lo(x[i][j][e]), inv, I8_MAGIC); q[2 * e + 1] = __builtin_fmaf(pg8::bf_hi(x[i][j][e]), inv, I8_MAGIC); }
                v2u o; o.x = pack4_i8(q[0], q[1], q[2], q[3]); o.y = pack4_i8(q[4], q[5], q[6], q[7]);
                *(v2u*)(Q + (size_t)(m + i) * DFF + j * 512 + lane * 8) = o; }
            if (lane == 0) rsu[m + i] = am * (1.0f / 127.0f); }
    }
}
__device__ __forceinline__ void cvt_item(const float* __restrict__ W, int ldw, int c0, int k0, const float* __restrict__ gain, bf16* dst, int K, int n0, LAS float* scr, int lane) {
    const int c = lane & 7;
    if (c0 < 0) {
#pragma unroll
        for (int j = 0; j < 4; ++j) { const int n = (lane >> 3) + 8 * j; *(v4u*)(dst + (size_t)(n0 + n) * K + k0 + 8 * c) = (v4u){0u, 0u, 0u, 0u}; }
        return;
    }
#pragma unroll
    for (int i = 0; i < 8; ++i) { const int kk = 8 * i + (lane >> 3);
        f32x4 v = *(const f32x4*)(W + (size_t)(k0 + kk) * ldw + c0 + 4 * c);
        if (gain) v = v * gain[k0 + kk];
        LAS float* s = scr + kk * 33 + 4 * c; s[0] = v[0]; s[1] = v[1]; s[2] = v[2]; s[3] = v[3]; }
    LDS_WAIT(); asm volatile("" ::: "memory");
#pragma unroll
    for (int j = 0; j < 4; ++j) { const int n = (lane >> 3) + 8 * j; const LAS float* s = scr + (8 * c) * 33 + n;
        v4u o; o.x = pk2(s[0 * 33], s[1 * 33]); o.y = pk2(s[2 * 33], s[3 * 33]); o.z = pk2(s[4 * 33], s[5 * 33]); o.w = pk2(s[6 * 33], s[7 * 33]);
        *(v4u*)(dst + (size_t)(n0 + n) * K + k0 + 8 * c) = o; }
    LDS_WAIT(); asm volatile("" ::: "memory");
}
__device__ __forceinline__ float wave_sum(float v) {
#pragma unroll
    for (int o = 1; o < 64; o <<= 1) v += __shfl_xor(v, o);
    return v;
}

__device__ __forceinline__ int opaque_i(int v) { asm volatile("" : "+s"(v)); return v; }
struct Args { const void* in[29]; float* out; unsigned char* ws; };

__device__ __forceinline__ int win_src_col(int g32) {
    const int tile = g32 >> 3, bj = (g32 >> 2) & 1, wc = g32 & 3;
    if (tile < 4) return (4 * tile + wc) * 64 + 32 * bj;
    if (tile == 4) return 1024 + wc * 64 + 32 * bj;
    if (tile < 9) return 1280 + (tile - 5) * 256 + (g32 & 7) * 32;
    return wc == 0 ? 2304 + 32 * bj : -1;
}

__device__ __forceinline__ bool quant_prepass(const pg8::StaticOrder& S, const bf16* X, unsigned char* ws, LAS float* rst, volatile LAS int* pnl, int& nu, bool use_group, bool grp_local, int bxi, unsigned& gseq, int wv) {
    const int tidq = TIDX(wv), laneq = tidq & 63, waveq = wv;
    signed char* Q8 = (signed char*)(ws + WS_QA8); float* rsg = (float*)(ws + WS_RSQ8);
    bool onepanel = true; int n = 0, p0 = -1;
    const bool split = use_group;
    if (split) {
        const int c = S.c, nN = S.nN; p0 = 8 * (c & 7) + ((c >> 3) & 7); n = (S.nwg - c + 255) >> 8;
        if (pnl && tidq < n && tidq < CS_UNITS) { const int p = 4 * tidq + (c >> 6) + (((c & 7) * nN) >> 3); pnl[tidq] = p >= nN ? p - nN : p; }
    } else { pg8::Unit ui_; for (int i_ = 0; S.next(i_, ui_); ++i_) { if (i_ == 0) p0 = ui_.pm; onepanel = onepanel && (ui_.pm == p0); ++n; if (pnl && tidq == 0 && i_ < CS_UNITS) pnl[i_] = ui_.pn; } }
    nu = n;
    if (split) {
        quant_panel<8>(X, Q8, rsg, (LAS float*)nullptr, p0 * 256, p0 * 256 + (bxi >> 6) * 64 + waveq * 8, 1, laneq);
        unsigned* ctl = (unsigned*)(ws + WS_CTL); gseq += 4u; group_barrier(ctl + CW_GRP + 64 * p0, gseq, ctl + CW_BAR + XB_TMO, wv, grp_local);
        if (tidq < 256) rst[tidq] = rsg[p0 * 256 + tidq];
    } else { pg8::Unit ui_; int prev = -1;
        for (int i_ = 0; S.next(i_, ui_); ++i_) if (ui_.pm != prev) { quant_panel(X, Q8, rsg, i_ == 0 ? rst : (LAS float*)nullptr, ui_.pm * 256, ui_.pm * 256 + waveq * 32, 8, laneq); prev = ui_.pm; } }
    return onepanel;
}
#define ONE_PANEL(S_, u0_, flag_) do { pg8::Unit ui_; flag_ = S_.next(0, u0_); for (int i_ = 1; S_.next(i_, ui_); ++i_) flag_ = flag_ && (ui_.pm == u0_.pm); } while (0)
#define FILL_RS(tab_, slot_, pm_) do { const int tq_ = TIDX(wave); if (tq_ < 256) { const float* p_ = (slot_) + (size_t)((pm_) * 256 + tq_) * 32; float t_ = 0.f; \
        _Pragma("unroll") for (int j_ = 0; j_ < 8; ++j_) { const f32x4 v_ = *(const f32x4*)(p_ + 4 * j_); t_ += (v_[0] + v_[1]) + (v_[2] + v_[3]); } \
        (tab_)[tq_] = pg8::rsq(t_ * (1.0f / DM) + EPS); } } while (0)
__global__ void __launch_bounds__(NWAVES * 64, 2) hybrid_fwd(Args args) {
    extern __shared__ __attribute__((aligned(16))) unsigned char lds_raw[];
    LAS unsigned char* lds = (LAS unsigned char*)lds_raw;
    volatile LAS unsigned* MISC = (volatile LAS unsigned*)(lds + MISC_OFF);
    const int tid = threadIdx.x, lane = tid & 63, wave = __builtin_amdgcn_readfirstlane(tid >> 6);
    const int G = gridDim.x, bx = blockIdx.x, vcu = (G % 8 == 0) ? (bx % 8) * (G / 8) + bx / 8 : bx;
    const KArg ka0 = (KArg)__builtin_amdgcn_kernarg_segment_ptr();
    for (int u = tid; u < (LDS_BYTES - MISC_OFF) / 4; u += NWAVES * 64) ((LAS unsigned*)(lds + MISC_OFF))[u] = 0u;
    __syncthreads();
    XcdBarrier bar = xcd_barrier_post((unsigned*)(ka_ptr<unsigned char>(ka0, KA_WS) + WS_CTL) + CW_BAR, MISC + 8, wave);
#define GRID_BAR() xcd_barrier(bar, wave)
    unsigned gseq = 0u;
    bool use_group;
    { bool okc = (G == 256);
      if (okc && tid < 256) { const int c = tid, pg = 8 * (c % 8) + (c / 8) % 8;
          for (int w = 0; w < 3; ++w) { pg8::StaticOrder T; T.init(MROWS, w == 0 ? 11264 : w == 1 ? DM : NIN, G, c); pg8::Unit ui_; int n_ = 0; for (int i_ = 0; T.next(i_, ui_); ++i_) { okc = okc && (ui_.pm == pg); ++n_; } okc = okc && (n_ > 0) && (n_ <= CS_UNITS); } }
      if (!okc) MISC[12] = 1u;
      __syncthreads();
      use_group = (MISC[12] == 0u); }
    if (use_group && tid == 0) __hip_atomic_store((unsigned*)(ka_ptr<unsigned char>(ka0, KA_WS) + WS_CTL) + CW_GXCC + 4 * (8 * (bx % 8) + (bx / 8) % 8) + (bx >> 6), bar.x + 1u, __ATOMIC_RELAXED, __HIP_MEMORY_SCOPE_AGENT);
    bool grp_local = false;
#define GROUP_BAR() do { if (use_group) { unsigned* ctl_ = (unsigned*)(ka_ptr<unsigned char>(ka_fresh(ka0), KA_WS) + WS_CTL); gseq += 4u; group_barrier(ctl_ + CW_GRP + 64 * (8 * (bxi % 8) + (bxi / 8) % 8), gseq, ctl_ + CW_BAR + XB_TMO, wave, grp_local); } else xcd_barrier(bar, wave); } while (0)
#define KIN(k, i) ((const float*)ka_ptr<const void>(k, i))
    const int gw = vcu * NWAVES + wave, NGW = G * NWAVES;

#ifndef DBG_NO_P0
    for (int rep_ = 0; rep_ < PROBE_DUP_P0; ++rep_) {
        const KArg k = ka_fresh(ka0); unsigned char* ws = ka_ptr<unsigned char>(k, KA_WS);
        LAS float* scr = (LAS float*)(lds + wave * 16384);
        constexpr int I_GU = (11264 / 32) * (2048 / 64), I_D = (2048 / 32) * (5632 / 64), I_IN = (NIN / 32) * (2048 / 64), I_UQ = (2048 / 32) * (512 / 64), I_UKV = (2048 / 32) * (256 / 64),
                      I_O = (2048 / 32) * (2048 / 64), I_PG = I_O, I_PP = (2048 / 32) * (256 / 64);
        constexpr int I_LAYER = I_IN + I_UQ + I_UKV + I_O + I_PP;
        { const float* xin = KIN(k, 0); bf16* HB = (bf16*)(ws + WS_HB2);
          for (int m = gw; m < MROWS; m += NGW) {
#pragma unroll
              for (int j = 0; j < 4; ++j) { const int col = j * 512 + lane * 8; const f32x4 a = *(const f32x4*)(xin + (size_t)m * DM + col), b2 = *(const f32x4*)(xin + (size_t)m * DM + col + 4);
                  v4u o; o.x = pk2(a[0], a[1]); o.y = pk2(a[2], a[3]); o.z = pk2(b2[0], b2[1]); o.w = pk2(b2[2], b2[3]); *(v4u*)(HB + (size_t)m * DM + col) = o; } } }
        { const float* pin = KIN(k, 1); bf16* PB = (bf16*)(ws + WS_PB); const size_t n8 = (size_t)DEPTH * MROWS * PLE / 8;
          for (size_t i = (size_t)bx * 512 + tid; i < n8; i += (size_t)G * 512) { const f32x4 a = *(const f32x4*)(pin + i * 8), b2 = *(const f32x4*)(pin + i * 8 + 4);
              v4u o; o.x = pk2(a[0], a[1]); o.y = pk2(a[2], a[3]); o.z = pk2(b2[0], b2[1]); o.w = pk2(b2[2], b2[3]); *(v4u*)(PB + i * 8) = o; } }
        { const int* positions = ka_ptr<const int>(k, 2); float* ROPEC = (float*)(ws + WS_ROPEC); float* ROPES = (float*)(ws + WS_ROPES);
          for (int i = bx * 512 + tid; i < MROWS * 32; i += G * 512) { const int m = i >> 5, kk = i & 31;
            const float inv = powf(10000.0f, -(float)kk / 32.0f), ang = (float)positions[m] * inv;
            ROPEC[i] = cosf(ang); ROPES[i] = sinf(ang); } }
        for (int it = gw; it < DEPTH * I_LAYER; it += NGW) {
            const int l = (DEPTH - 1) - it / I_LAYER; int r = (I_LAYER - 1) - it % I_LAYER;
            unsigned char* wl = ws + WS_W + (size_t)l * W_LAYER;
            if (r < I_IN) { const int g32 = r / 32, kb = r % 32;
                cvt_item(KIN(k, 8) + (size_t)l * DM * 2368, 2368, win_src_col(g32), kb * 64, KIN(k, 7) + l * DM, (bf16*)(wl + W_IN), DM, g32 * 32, scr, lane); continue; }
            r -= I_IN;
            if (r < I_UQ) { const int g32 = r / 8, kb = r % 8, h = g32 >> 3, bj = (g32 >> 2) & 1, wc = g32 & 3;
                cvt_item(KIN(k, 13) + (size_t)l * 512 * 1536, 1536, wc < 3 ? h * 192 + 64 * wc + 32 * bj : -1, kb * 64, KIN(k, 12) + l * 512, (bf16*)(wl + W_UQ), 512, g32 * 32, scr, lane); continue; }
            r -= I_UQ;
            if (r < I_UKV) { const int g32 = r / 4, kb = r % 4;
                cvt_item(KIN(k, 15) + (size_t)l * 256 * 2048, 2048, g32 * 32, kb * 64, KIN(k, 14) + l * 256, (bf16*)(wl + W_UKV), 256, g32 * 32, scr, lane); continue; }
            r -= I_UKV;
            if (r < I_O) { const int g32 = r / 32, kb = r % 32;
                const float* gain = kb < 16 ? KIN(k, 18) + l * 1024 : KIN(k, 19) + l * 1024 - 1024;
                cvt_item(KIN(k, 20) + (size_t)l * DM * DM, DM, g32 * 32, kb * 64, gain, (bf16*)(wl + W_O), DM, g32 * 32, scr, lane); continue; }
            r -= I_O;
            { const int g32 = r / 4, kb = r % 4;
                cvt_item(KIN(k, 25) + (size_t)l * PLE * DM, DM, g32 * 32, kb * 64, nullptr, (bf16*)(wl + W_PP), PLE, g32 * 32, scr, lane); }
        }
        { LAS float* cmx = (LAS float*)(lds + EPI_T_OFF);
          for (int s = bx; s < DEPTH * 64; s += G) { const int l = s / 64, g32 = s % 64; int ln_ = lane; asm volatile("" : "+v"(ln_));
              cvt_strip8(KIN(k, 28) + (size_t)l * DM * DM, DM, g32 * 32, KIN(k, 27) + l * DM, (signed char*)(ws + WS_W + (size_t)l * W_LAYER + W_PG), g32 * 32, (float*)(ws + WS_WSCP) + (size_t)l * DM, scr, cmx, wave, ln_); } }
        { LAS float* cmx = (LAS float*)(lds + EPI_T_OFF); constexpr int NSTRIPD = DEPTH * 2 * 64;
          for (int s = bx; s < NSTRIPD; s += G) { const int l = (DEPTH - 1) - s / 128, r = s % 128, f = 1 - r / 64, g32 = r % 64;
              int ln_ = lane; asm volatile("" : "+v"(ln_));
              cvt_strip8_2p(KIN(k, f ? 24 : 6) + (size_t)l * DFF * DM, DM, g32 * 32, DFF / 64, (signed char*)(ws + WS_W + (size_t)l * W_LAYER + (f ? W_2D : W_1D)), DFF, g32 * 32, (float*)(ws + WS_WSCD) + (size_t)(l * 2 + f) * DM, scr, cmx, wave, ln_); } }
        { LAS float* cmx = (LAS float*)(lds + EPI_T_OFF); constexpr int NSTRIP = DEPTH * 2 * 352;
          for (int s = bx; s < NSTRIP; s += G) { const int l = (DEPTH - 1) - s / 704, r = s % 704, f = 1 - r / 352, g32 = r % 352, tile = g32 >> 3, bj = (g32 >> 2) & 1, q = g32 & 3;
              const float* src = KIN(k, f ? (bj ? 23 : 22) : (bj ? 5 : 4)) + (size_t)l * DM * DFF; const float* gain = KIN(k, f ? 21 : 3) + l * DM;
              int ln_ = lane; asm volatile("" : "+v"(ln_));
              cvt_strip8(src, DFF, tile * 128 + q * 32, gain, (signed char*)(ws + WS_W + (size_t)l * W_LAYER + (f ? W_2GU : W_1GU)), g32 * 32, (float*)(ws + WS_WSC) + (size_t)(l * 2 + f) * 11264, scr, cmx, wave, ln_); } }
    }
#endif
    GRID_BAR();
    if (use_group) { if (tid == 0) { unsigned* gx = (unsigned*)(ka_ptr<unsigned char>(ka0, KA_WS) + WS_CTL) + CW_GXCC + 4 * (8 * (bx % 8) + (bx / 8) % 8);
                                     const unsigned x0 = xb_ld(gx), x1 = xb_ld(gx + 1), x2 = xb_ld(gx + 2), x3 = xb_ld(gx + 3); MISC[13] = (x0 != 0u && x0 == x1 && x0 == x2 && x0 == x3) ? 1u : 0u; }
                     __syncthreads(); grp_local = (MISC[13] != 0u); }

    LAS float* epiT = (LAS float*)(lds + EPI_T_OFF);
    for (int hl = 0; hl < 2 * DEPTH; ++hl) {
        int Gi = G, bxi = bx; asm volatile("" : "+s"(Gi), "+s"(bxi));
        const int l = hl >> 1, second = hl & 1;
        { const KArg k = ka_fresh(ka0); unsigned char* ws = ka_ptr<unsigned char>(k, KA_WS);
          pg8::Gemm g{(const bf16*)(ws + WS_QA8), (const bf16*)(ws + WS_W + (size_t)l * W_LAYER + (second ? W_2GU : W_1GU)), MROWS, 11264, DM / 2}; pg8::StaticOrder S; S.init(MROWS, 11264, Gi, bxi);
          LAS float* rst = (LAS float*)(lds + RS_OFF); LAS float* cst = (LAS float*)(lds + CS_OFF); volatile LAS int* pnl = (volatile LAS int*)(lds + EPI_T_OFF);
          int nu = 0; const int tidq = TIDX(wave);
          const bool onepanel = quant_prepass(S, (const bf16*)(ws + (second ? WS_HB : WS_HB2)), ws, rst, pnl, nu, use_group, grp_local, bxi, gseq, wave);
          const bool usetab = onepanel && nu <= CS_UNITS;
          const size_t wsc_off = WS_WSC + (size_t)(l * 2 + second) * 11264 * 4;
          __syncthreads();
          if (usetab) { const float* wsc = (const float*)(ws + wsc_off); float cv[CS_UNITS / 2]; const int tid = tidq;
#pragma unroll
              for (int j = 0; j < CS_UNITS / 2; ++j) { const int idx = j * 512 + tid; cv[j] = (idx >> 8) < nu ? wsc[pnl[idx >> 8] * 256 + (idx & 255)] : 0.f; }
#pragma unroll
              for (int j = 0; j < CS_UNITS / 2; ++j) cst[j * 512 + tid] = cv[j]; }
          VM_WAIT(); __syncthreads();
          pg8::EpiSwiGLU8 E{ka0, onepanel ? (const LAS float*)rst : (const LAS float*)nullptr, usetab ? (const LAS float*)cst : (const LAS float*)nullptr, wsc_off, (bf16*)(ws + WS_U)};
#if !defined(DBG_ONLY) || DBG_ONLY == 0
          pg8::gemm_phase<pg8::EpiSwiGLU8, pg8::StaticOrder, true, true, true>(lds, g, S, E, wave);
#endif
        }
        GROUP_BAR();
        { const KArg k = ka_fresh(ka0); unsigned char* ws = ka_ptr<unsigned char>(k, KA_WS); const int tq_ = TIDX(wave), wq_ = wave;
          if (use_group) { const int m0 = (8 * (bxi % 8) + (bxi / 8) % 8) * 256 + (bxi >> 6) * 64 + wq_ * 8; quant_rows_u((const bf16*)(ws + WS_U), (signed char*)(ws + WS_QU8), (float*)(ws + WS_RSU), m0, m0 + 8, 2, tq_ & 63); }
          else { const int vcu_ = (Gi % 8 == 0) ? (bxi % 8) * (Gi / 8) + bxi / 8 : bxi; quant_rows_u((const bf16*)(ws + WS_U), (signed char*)(ws + WS_QU8), (float*)(ws + WS_RSU), 2 * (vcu_ * NWAVES + wq_), MROWS, 2 * Gi * NWAVES, tq_ & 63); } }
        GROUP_BAR();
        { const KArg k = ka_fresh(ka0); unsigned char* ws = ka_ptr<unsigned char>(k, KA_WS);
          pg8::Gemm g{(const bf16*)(ws + WS_QU8), (const bf16*)(ws + WS_W + (size_t)l * W_LAYER + (second ? W_2D : W_1D)), MROWS, DM, DFF / 2}; pg8::StaticOrder S; S.init(MROWS, DM, Gi, bxi);
          pg8::EpiResid8 E{ka0, second ? -1 : (int)SS_1, 0.5f, second ? WS_HB : WS_HB2, WS_HB, WS_WSCD + (size_t)(l * 2 + second) * DM * 4};
#if !defined(DBG_ONLY) || DBG_ONLY == 1
          pg8::gemm_phase<pg8::EpiResid8, pg8::StaticOrder, true, true, true>(lds, g, S, E, wave);
#endif
        }
        GROUP_BAR();
        if (!second) {
            { const KArg k = ka_fresh(ka0); unsigned char* ws = ka_ptr<unsigned char>(k, KA_WS);
              pg8::Gemm g{(const bf16*)(ws + WS_HB), (const bf16*)(ws + WS_W + (size_t)l * W_LAYER + W_IN), MROWS, NIN, DM}; pg8::StaticOrder S; S.init(MROWS, NIN, Gi, bxi);
              LAS float* rst = (LAS float*)(lds + RS_OFF); bool onepanel; pg8::Unit u0; ONE_PANEL(S, u0, onepanel);
              if (onepanel) { FILL_RS(rst, ka_stats(k, SS_1), u0.pm); __syncthreads(); }
              pg8::EpiWin E{ka0, l, onepanel ? (const LAS float*)rst : (const LAS float*)nullptr};
#if !defined(DBG_ONLY) || DBG_ONLY == 2
              pg8::gemm_phase<pg8::EpiWin, pg8::StaticOrder, true, true>(lds, g, S, E, wave);
#endif
            }
            { const KArg k = ka_fresh(ka0); unsigned char* ws = ka_ptr<unsigned char>(k, KA_WS);
              pg8::Gemm g{(const bf16*)(ws + WS_PB) + (size_t)l * MROWS * PLE, (const bf16*)(ws + WS_W + (size_t)l * W_LAYER + W_PP), MROWS, 2048, opaque_i(PLE)}; pg8::StaticOrder S;
              { const int rem = ((MROWS / 256) * (NIN / 256)) % Gi, nl = Gi - rem;
                if (rem != 0 && rem % 8 == 0 && nl % 8 == 0) S.init(MROWS, 2048, nl, bxi >= rem ? bxi - rem : (1 << 20)); else S.init(MROWS, 2048, Gi, bxi); }
              pg8::EpiStoreSsq E{ka0, (l & 1) ? (int)SS_PP2 : (int)SS_PP, (l & 1) ? WS_PP2 : WS_PP};
#if !defined(DBG_ONLY) || DBG_ONLY == 5
              pg8::gemm_phase<pg8::EpiStoreSsq, pg8::StaticOrder, true, true>(lds, g, S, E, wave);
#endif
            }
            GROUP_BAR();
            { const KArg k = ka_fresh(ka0); unsigned char* ws = ka_ptr<unsigned char>(k, KA_WS);
              pg8::Gemm g{(const bf16*)(ws + WS_CQ), (const bf16*)(ws + WS_W + (size_t)l * W_LAYER + W_UQ), MROWS, 2048, opaque_i(512)}; pg8::StaticOrder S; S.init(MROWS, 2048, Gi, bxi);
              pg8::EpiQB E{ka0, l, epiT};
#if !defined(DBG_ONLY) || DBG_ONLY == 3
              pg8::gemm_phase<pg8::EpiQB, pg8::StaticOrder, true, true>(lds, g, S, E, wave);
#endif
            }
            { const KArg k = ka_fresh(ka0); unsigned char* ws = ka_ptr<unsigned char>(k, KA_WS);
              pg8::Gemm g{(const bf16*)(ws + WS_CKV), (const bf16*)(ws + WS_W + (size_t)l * W_LAYER + W_UKV), MROWS, 2048, opaque_i(256)}; pg8::StaticOrder S; S.init(MROWS, 2048, Gi, bxi);
              pg8::EpiKV E{ka0, l, epiT};
#if !defined(DBG_ONLY) || DBG_ONLY == 4
              pg8::gemm_phase<pg8::EpiKV, pg8::StaticOrder, true, true>(lds, g, S, E, wave);
#endif
            }
            GRID_BAR();
            for (int rep_ = 0; rep_ < PROBE_DUP_ATT; ++rep_) { const KArg k = ka_fresh(ka0); unsigned char* ws = ka_ptr<unsigned char>(k, KA_WS);
#ifndef DBG_NO_MLA
              for (int pi = vcu; pi < 256; pi += G) { const int bh = pi >> 4, s = pi & 15;
                att::mla_unit(bh >> 3, bh & 7, 31 - s, (const short*)(ws + WS_QB), (const short*)(ws + WS_KB), (const short*)(ws + WS_VB), (const float*)(ws + WS_ROPEC), (const float*)(ws + WS_ROPES), (short*)(ws + WS_O), (att::lptr)lds, wave);
                att::mla_unit(bh >> 3, bh & 7, s, (const short*)(ws + WS_QB), (const short*)(ws + WS_KB), (const short*)(ws + WS_VB), (const float*)(ws + WS_ROPEC), (const float*)(ws + WS_ROPES), (short*)(ws + WS_O), (att::lptr)lds, wave); }
#endif
#ifndef DBG_NO_SWA
              for (int si = vcu; si < 512; si += G) { const int b = si >> 8, kvh = (si >> 6) & 3, n = si & 63;
                att::swa_unit(b, kvh, n, (const short*)(ws + WS_QA), (const short*)(ws + WS_KA), (const short*)(ws + WS_VA), ka_ptr<const int>(k, 2), KIN(k, 11) + l * 16, (short*)(ws + WS_O), (att::lptr)lds, wave); }
#endif
            }
            GRID_BAR();
            { const KArg k = ka_fresh(ka0); bf16* O = (bf16*)(ka_ptr<unsigned char>(k, KA_WS) + WS_O);
              const int ln_ = lane_id();
              const int mb_ = use_group ? (8 * (bxi % 8) + (bxi / 8) % 8) * 256 + (bxi >> 6) * 64 + wave * 8 : gw, me_ = use_group ? mb_ + 8 : MROWS, ms_ = use_group ? 1 : NGW;
              for (int m = mb_; m < me_; m += ms_) { const int half = ln_ >> 5, l32 = ln_ & 31; bf16* op = O + (size_t)m * DM + half * 1024 + l32 * 8;
                v4u w[4]; float s = 0.f;
#pragma unroll
                for (int j = 0; j < 4; ++j) { w[j] = *(const v4u*)(op + j * 256);
#pragma unroll
                    for (int e = 0; e < 4; ++e) { const float a = pg8::bf_lo(w[j][e]), b2 = pg8::bf_hi(w[j][e]); s += a * a + b2 * b2; } }
#pragma unroll
                for (int o = 1; o < 32; o <<= 1) s += __shfl_xor(s, o);
                const float r = pg8::rsq(s * (1.0f / 1024.0f) + EPS);
#pragma unroll
                for (int j = 0; j < 4; ++j) { v4u o;
#pragma unroll
                    for (int e = 0; e < 4; ++e) o[e] = pk2(pg8::bf_lo(w[j][e]) * r, pg8::bf_hi(w[j][e]) * r);
                    *(v4u*)(op + j * 256) = o; } } }
            GROUP_BAR();
            { const KArg k = ka_fresh(ka0); unsigned char* ws = ka_ptr<unsigned char>(k, KA_WS);
              pg8::Gemm g{(const bf16*)(ws + WS_O), (const bf16*)(ws + WS_W + (size_t)l * W_LAYER + W_O), MROWS, DM, DM}; pg8::StaticOrder S; S.init(MROWS, DM, Gi, bxi);
              pg8::EpiResid E{ka0, -1, 1.0f, WS_HB, WS_HB};
#if !defined(DBG_ONLY) || DBG_ONLY == 6
              pg8::gemm_phase<pg8::EpiResid, pg8::StaticOrder, true, true>(lds, g, S, E, wave);
#endif
            }
            GROUP_BAR();
        } else {
            { const KArg k = ka_fresh(ka0); unsigned char* ws = ka_ptr<unsigned char>(k, KA_WS);
              pg8::Gemm g{(const bf16*)(ws + WS_QA8), (const bf16*)(ws + WS_W + (size_t)l * W_LAYER + W_PG), MROWS, DM, DM / 2}; pg8::StaticOrder S; S.init(MROWS, DM, Gi, bxi);
              LAS float* rst = (LAS float*)(lds + RS_OFF); pg8::Unit u0; int nu_ = 0; (void)S.next(0, u0);
              const bool onepanel = quant_prepass(S, (const bf16*)(ws + WS_HB), ws, rst, (volatile LAS int*)nullptr, nu_, use_group, grp_local, bxi, gseq, wave);
              if (onepanel) { FILL_RS(rst + 256, ka_stats(k, (l & 1) ? (int)SS_PP2 : (int)SS_PP), u0.pm); }
              VM_WAIT(); __syncthreads();
              pg8::EpiPle E{ka0, l, onepanel ? (const LAS float*)rst : (const LAS float*)nullptr, WS_WSCP + (size_t)l * DM * 4, (l & 1) ? WS_PP2 : WS_PP, (l & 1) ? (int)SS_PP2 : (int)SS_PP};
#if !defined(DBG_ONLY) || DBG_ONLY == 7
              pg8::gemm_phase<pg8::EpiPle, pg8::StaticOrder, true, true, true>(lds, g, S, E, wave);
#endif
            }
            if (hl + 1 < 2 * DEPTH) GROUP_BAR();
        }
    }
}

extern "C" void kernel_launch(void* const* d_in, const int* in_sizes, int n_in, void* d_out, int out_size, void* d_ws, size_t ws_size, hipStream_t stream) {
    static int grid = 0;
    if (grid == 0) {
        if (n_in != 29 || out_size != MROWS * DM || ws_size < WS_END) { fprintf(stderr, "kernel_launch: unexpected shapes (n_in %d, out %d, ws %zu < %zu); nothing launched\n", n_in, out_size, ws_size, (size_t)WS_END); grid = -1; return; }
        int dev = 0, cus = 0, per_cu = 0;
        if (hipGetDevice(&dev) != hipSuccess || hipDeviceGetAttribute(&cus, hipDeviceAttributeMultiprocessorCount, dev) != hipSuccess) { grid = -1; return; }
        if (hipFuncSetAttribute((const void*)hybrid_fwd, hipFuncAttributeMaxDynamicSharedMemorySize, LDS_BYTES) != hipSuccess) { fprintf(stderr, "kernel_launch: hipFuncSetAttribute failed\n"); grid = -1; return; }
        if (hipOccupancyMaxActiveBlocksPerMultiprocessor(&per_cu, (const void*)hybrid_fwd, NWAVES * 64, LDS_BYTES) != hipSuccess || per_cu < 1)
            fprintf(stderr, "kernel_launch: note: occupancy query reports %d workgroups per CU\n", per_cu);
        (void)hipGetLastError();
        grid = cus;
    }
    if (grid < 0) return;
    if (hipMemsetAsync((char*)d_ws + WS_CTL, 0, ZERO_BYTES, stream) != hipSuccess) { fprintf(stderr, "kernel_launch: hipMemsetAsync failed\n"); return; }
    Args a{};
    for (int i = 0; i < 29; ++i) a.in[i] = d_in[i];
    a.out = (float*)d_out; a.ws = (unsigned char*)d_ws;
    hipLaunchKernelGGL(hybrid_fwd, dim3(grid), dim3(NWAVES * 64), LDS_BYTES, stream, a);
    const hipError_t le = hipPeekAtLastError();
    if (le != hipSuccess) fprintf(stderr, "kernel_launch: launch failed: %s\n", hipGetErrorName(le));
}
```

```cpp
#include <hip/hip_runtime.h>
#include <cstdio>
#include <cstdint>
#include <cmath>
__device__ __forceinline__ int lane_id() { int z = 0; asm volatile("" : "+v"(z)); return (int)__builtin_amdgcn_mbcnt_hi(~0u, __builtin_amdgcn_mbcnt_lo(~0u, (unsigned)z)); }
#define TIDX(wv) (((wv) << 6) | lane_id())
namespace pg8 {
#define PG8_LAS __attribute__((address_space(3)))
typedef unsigned short bf16_t;
typedef short bf16x8 __attribute__((ext_vector_type(8)));
typedef float f32x4 __attribute__((ext_vector_type(4)));
typedef unsigned u32x4 __attribute__((ext_vector_type(4)));
constexpr int BM = 256, BK = 64, HALF = 128, HTB = HALF * BK * 2  , STAGE_BYTES = 8 * HTB, NXCD = 8, WGM = 8;

__host__ __device__ __forceinline__ int lds_byte(int r, int c) { const int st = (r >> 4) * 2 + (c >> 5), rr = r & 15, cc = c & 31, ob = rr * 64 + cc * 2; return st * 1024 + (ob ^ (((ob >> 9) & 1) << 5)); }
__host__ __device__ __forceinline__ void stage_rc(int b, int& R, int& C) { const int st = b / 1024, sb = b % 1024, swz = sb ^ (((sb >> 9) & 1) << 5); R = (st >> 1) * 16 + swz / 64; C = (st & 1) * 32 + (swz % 64) / 2; }
__host__ __device__ __forceinline__ int perm32(int rho) { const int n = rho >> 4, i = rho & 15; return 8 * (i >> 2) + 4 * n + (i & 3); }

typedef int i32x4 __attribute__((ext_vector_type(4)));
template <bool I8> __device__ __forceinline__ f32x4 mma1(bf16x8 b, bf16x8 a, f32x4 c) {
    if constexpr (I8) return __builtin_bit_cast(f32x4, __builtin_amdgcn_mfma_i32_16x16x64_i8(__builtin_bit_cast(i32x4, b), __builtin_bit_cast(i32x4, a), __builtin_bit_cast(i32x4, c), 0, 0, 0));
    else return __builtin_amdgcn_mfma_f32_16x16x32_bf16(b, a, c, 0, 0, 0);
}
struct Unit { int pm, pn; };
struct Gemm { const bf16_t* A; const bf16_t* Bt; int M, N, K; };

struct StaticOrder {
    int nM, nN, nwg, G, c;
    __host__ __device__ void init(int M, int N, int G_, int c_) { nM = M / BM; nN = N / BM; nwg = nM * nN; G = G_; c = c_; }
    __host__ __device__ __forceinline__ bool next(int i, Unit& u) const {
        const long L = (long)i * G + c; if (L >= nwg) return false;
        int wgid = (int)L; { const int q = nwg / NXCD, r = nwg % NXCD, xcd = wgid % NXCD, off = wgid / NXCD; wgid = (xcd < r ? xcd * (q + 1) : r * (q + 1) + (xcd - r) * q) + off; }
        const int nig = WGM * nN, gid = wgid / nig, fm = gid * WGM, gsz = (nM - fm) < WGM ? (nM - fm) : WGM;
        u.pm = fm + ((wgid % nig) % gsz); u.pn = (wgid % nig) / gsz;
        { const int xc = (int)(L % NXCD); u.pn = (u.pn + (xc * nN) / NXCD) % nN; }
        return true;
    }
    __device__ __forceinline__ void a_ready(const Unit&) const {}
    __device__ __forceinline__ void done(const Unit&) const {}
};

typedef __bf16 bf16x2_t __attribute__((ext_vector_type(2)));
typedef float f32x2_t __attribute__((ext_vector_type(2)));
__device__ __forceinline__ unsigned cvt_pk_bf16(float lo, float hi) { const bf16x2_t r = __builtin_convertvector((f32x2_t){lo, hi}, bf16x2_t); return __builtin_bit_cast(unsigned, r); }
typedef float f32x2 __attribute__((ext_vector_type(2)));
template <class Epi, class Sched, bool ALIGN_EPI = false, bool SP2 = false, bool I8 = false>
__device__ __forceinline__ void gemm_phase(PG8_LAS unsigned char* lds, const Gemm g, const Sched& S, const Epi& E, int wv) {
    int tid_ = TIDX(wv);
    const int tid = tid_, wid = wv, lane = tid & 63, wr = wid >> 2, wc = wid & 3, fr = lane & 15, fq = lane >> 4;
    const int K = g.K, nt = K / BK;
    unsigned voffA[2], voffB[2];
#pragma unroll
    for (int i = 0; i < 2; ++i) { int R, C; stage_rc(tid * 16 + i * 8192, R, C); const int Rb = Epi::PERM ? ((R & ~31) + perm32(R & 31)) : R;
        voffA[i] = (unsigned)(R * K + C) * 2u; voffB[i] = (unsigned)(Rb * K + C) * 2u; }
    const size_t kstep = (size_t)(BK * 2);
    const size_t hstep = (size_t)HALF * K * 2;
    const size_t tstep = 2 * hstep;
    const unsigned ldsw = (unsigned)wid * 1024u;
    const int aoff = lds_byte(wr * 64 + fr, fq * 8), boff = lds_byte(wc * 32 + fr, fq * 8);
#define PG8_SA(b, h) (((b) * 2 + (h)) * HTB)
#define PG8_SB(b, h) ((4 + (b) * 2 + (h)) * HTB)
#define PG8_STAGE(bufoff, gbase, voff) do { _Pragma("unroll") for (int _i = 0; _i < 2; ++_i) \
        __builtin_amdgcn_global_load_lds((const unsigned*)((const char*)(gbase) + (voff)[_i]), (PG8_LAS unsigned*)(lds + (bufoff) + ldsw + _i * 8192), 16, 0, 0); } while (0)
#define PG8_LDA(dst, b, h) do { _Pragma("unroll") for (int m = 0; m < 4; ++m) _Pragma("unroll") for (int k = 0; k < 2; ++k) dst[m][k] = *(const PG8_LAS bf16x8*)(lds + PG8_SA(b, h) + aoff + m * 2048 + k * 1024); } while (0)
#define PG8_LDB(dst, b, h) do { _Pragma("unroll") for (int n = 0; n < 2; ++n) _Pragma("unroll") for (int k = 0; k < 2; ++k) dst[n][k] = *(const PG8_LAS bf16x8*)(lds + PG8_SB(b, h) + boff + n * 2048 + k * 1024); } while (0)
#define PG8_MMA(ai, bj, At, Bt) do { __builtin_amdgcn_s_setprio(1); _Pragma("unroll") for (int m = 0; m < 4; ++m) _Pragma("unroll") for (int n = 0; n < 2; ++n) _Pragma("unroll") for (int k = 0; k < 2; ++k) \
        acc[ai][bj][m][n] = mma1<I8>(Bt[n][k], At[m][k], acc[ai][bj][m][n]); __builtin_amdgcn_s_setprio(0); } while (0)
#define PG8_WAIT_V(n) asm volatile("s_waitcnt vmcnt(" #n ")" ::: "memory")
#define PG8_WAIT_L(n) asm volatile("s_waitcnt lgkmcnt(" #n ")" ::: "memory")
#define PG8_BAR __builtin_amdgcn_s_barrier()
#define PG8_SCHED __builtin_amdgcn_sched_barrier(0)
    Unit cur, nxt; int ui = 0;
    if (!S.next(0, cur)) return;
    f32x4 acc[2][2][4][2];
#pragma unroll
    for (int a = 0; a < 2; ++a)
#pragma unroll
        for (int b = 0; b < 2; ++b)
#pragma unroll
            for (int m = 0; m < 4; ++m)
#pragma unroll
                for (int n = 0; n < 2; ++n) acc[a][b][m][n] = (f32x4){0.f, 0.f, 0.f, 0.f};
    bf16x8 At[4][2], B0[2][2], B1[2][2];
    const char* cA = (const char*)g.A + (size_t)cur.pm * tstep; const char* cB = (const char*)g.Bt + (size_t)cur.pn * tstep;
    S.a_ready(cur);
    if constexpr (SP2) {
        PG8_STAGE(PG8_SB(0, 0), cB, voffB); PG8_STAGE(PG8_SB(0, 1), cB + hstep, voffB); PG8_STAGE(PG8_SA(0, 0), cA, voffA); PG8_STAGE(PG8_SA(0, 1), cA + hstep, voffA);
        if (wr == 1) PG8_BAR;
        PG8_WAIT_V(2); PG8_BAR;
        PG8_STAGE(PG8_SB(1, 0), cB + kstep, voffB); PG8_STAGE(PG8_SA(1, 0), cA + kstep, voffA); PG8_STAGE(PG8_SB(1, 1), cB + hstep + kstep, voffB);
        PG8_WAIT_V(6); PG8_BAR;
    } else {
        PG8_STAGE(PG8_SB(0, 0), cB, voffB); PG8_STAGE(PG8_SA(0, 0), cA, voffA); PG8_STAGE(PG8_SB(0, 1), cB + hstep, voffB); PG8_STAGE(PG8_SA(0, 1), cA + hstep, voffA);
        if (wr == 1) PG8_BAR;
        PG8_WAIT_V(4); PG8_BAR;
        PG8_STAGE(PG8_SB(1, 0), cB + kstep, voffB); PG8_STAGE(PG8_SA(1, 0), cA + kstep, voffA); PG8_STAGE(PG8_SB(1, 1), cB + hstep + kstep, voffB);
        PG8_WAIT_V(6); PG8_BAR;
    }
    for (;;) {
        const bool has_next = S.next(ui + 1, nxt);
        const char* nA = has_next ? (const char*)g.A + (size_t)nxt.pm * tstep : cA; const char* nB = has_next ? (const char*)g.Bt + (size_t)nxt.pn * tstep : cB;
        for (int t = 0; t < nt; t += 2) {
            const bool last = (t == nt - 2);
            const char* a1 = cA + (size_t)(t + 1) * kstep;
            const char* a2 = last ? nA : cA + (size_t)(t + 2) * kstep; const char* b2 = last ? nB : cB + (size_t)(t + 2) * kstep;
            const char* a3 = a2 + kstep; const char* b3 = b2 + kstep;
            if (last && has_next) S.a_ready(nxt);
            if constexpr (SP2) {
            PG8_LDB(B0, 0, 0); PG8_LDB(B1, 0, 1); PG8_SCHED; PG8_LDA(At, 0, 0); PG8_STAGE(PG8_SA(1, 1), a1 + hstep, voffA);
            PG8_WAIT_V(8); PG8_WAIT_L(0); PG8_BAR; PG8_MMA(0, 0, At, B0); PG8_MMA(0, 1, At, B1); PG8_BAR; PG8_SCHED;
            PG8_LDA(At, 0, 1); PG8_STAGE(PG8_SB(0, 0), b2, voffB); PG8_STAGE(PG8_SB(0, 1), b2 + hstep, voffB); PG8_STAGE(PG8_SA(0, 0), a2, voffA);
            PG8_WAIT_V(8); PG8_WAIT_L(0); PG8_BAR; PG8_MMA(1, 0, At, B0); PG8_MMA(1, 1, At, B1); PG8_BAR; PG8_SCHED;
            PG8_LDB(B0, 1, 0); PG8_LDB(B1, 1, 1); PG8_SCHED; PG8_LDA(At, 1, 0); PG8_STAGE(PG8_SA(0, 1), a2 + hstep, voffA);
            PG8_WAIT_V(8); PG8_WAIT_L(0); PG8_BAR; PG8_MMA(0, 0, At, B0); PG8_MMA(0, 1, At, B1); PG8_BAR; PG8_SCHED;
            PG8_LDA(At, 1, 1); PG8_STAGE(PG8_SB(1, 0), b3, voffB); PG8_STAGE(PG8_SB(1, 1), b3 + hstep, voffB); PG8_STAGE(PG8_SA(1, 0), a3, voffA);
            PG8_WAIT_V(8); PG8_WAIT_L(0); PG8_BAR; PG8_MMA(1, 0, At, B0); PG8_MMA(1, 1, At, B1); PG8_BAR; PG8_SCHED;
            } else {
            PG8_LDB(B0, 0, 0); PG8_SCHED; PG8_LDA(At, 0, 0); PG8_STAGE(PG8_SA(1, 1), a1 + hstep, voffA);
            PG8_WAIT_L(8); PG8_BAR; PG8_WAIT_L(0); PG8_MMA(0, 0, At, B0); PG8_BAR; PG8_SCHED;
            PG8_LDB(B1, 0, 1); PG8_STAGE(PG8_SB(0, 0), b2, voffB);
            PG8_BAR; PG8_WAIT_L(0); PG8_MMA(0, 1, At, B1); PG8_BAR;
            PG8_LDA(At, 0, 1); PG8_STAGE(PG8_SA(0, 0), a2, voffA);
            PG8_BAR; PG8_WAIT_L(0); PG8_MMA(1, 0, At, B0); PG8_BAR; PG8_SCHED;
            PG8_STAGE(PG8_SB(0, 1), b2 + hstep, voffB);
            PG8_WAIT_V(6); PG8_BAR; PG8_MMA(1, 1, At, B1); PG8_BAR;
            PG8_LDB(B0, 1, 0); PG8_SCHED; PG8_LDA(At, 1, 0); PG8_STAGE(PG8_SA(0, 1), a2 + hstep, voffA);
            PG8_WAIT_L(8); PG8_BAR; PG8_WAIT_L(0); PG8_MMA(0, 0, At, B0); PG8_BAR; PG8_SCHED;
            PG8_LDB(B1, 1, 1); PG8_STAGE(PG8_SB(1, 0), b3, voffB);
            PG8_BAR; PG8_WAIT_L(0); PG8_MMA(0, 1, At, B1); PG8_BAR;
            PG8_LDA(At, 1, 1); PG8_STAGE(PG8_SA(1, 0), a3, voffA);
            PG8_BAR; PG8_WAIT_L(0); PG8_MMA(1, 0, At, B0); PG8_BAR; PG8_SCHED;
            PG8_STAGE(PG8_SB(1, 1), b3 + hstep, voffB);
            PG8_WAIT_V(6); PG8_BAR; PG8_MMA(1, 1, At, B1); PG8_BAR;
            }
        }
        if constexpr (ALIGN_EPI) { if (wr == 0) PG8_BAR; }
        if constexpr (!Epi::AFTER_DRAIN) { int z_ = 0; asm volatile("" : "+v"(z_)); const int le_ = __builtin_amdgcn_mbcnt_hi(~0u, __builtin_amdgcn_mbcnt_lo(~0u, (unsigned)z_));
            if constexpr (Epi::WANTS_UI) E(acc, cur, ui, wr, wc, le_ & 15, le_ >> 4); else E(acc, cur, wr, wc, le_ & 15, le_ >> 4); S.done(cur); }
        if (!has_next) break;
#pragma unroll
        for (int a = 0; a < 2; ++a)
#pragma unroll
            for (int b = 0; b < 2; ++b)
#pragma unroll
                for (int m = 0; m < 4; ++m)
#pragma unroll
                    for (int n = 0; n < 2; ++n) acc[a][b][m][n] = (f32x4){0.f, 0.f, 0.f, 0.f};
        cur = nxt; cA = nA; cB = nB; ++ui;
        if constexpr (ALIGN_EPI) { if (wr == 1) PG8_BAR; }
    }
    PG8_WAIT_V(0);
    if constexpr (!ALIGN_EPI) { if (wr == 0) PG8_BAR; }
    PG8_BAR;
    if constexpr (Epi::AFTER_DRAIN) { E.fused(acc, cur, wr, wc, fr, fq, lds, wid, lane); S.done(cur); }
#undef PG8_SA
#undef PG8_SB
#undef PG8_STAGE
#undef PG8_LDA
#undef PG8_LDB
#undef PG8_MMA
#undef PG8_WAIT_V
#undef PG8_WAIT_L
#undef PG8_BAR
#undef PG8_SCHED
}
}
constexpr int BATCH = 2, SEQ = 8192, MROWS = BATCH * SEQ, DM = 2048, DFF = 5632, DEPTH = 4, PLE = 256;
constexpr int NIN = 2560;
constexpr int QB_PITCH = 1536, KB_PITCH = 1536, VB_PITCH = 1024, QA_PITCH = 1024, KA_PITCH = 256, VA_PITCH = 256;
constexpr float EPS = 1e-6f, LOG2E = 1.4426950408889634f;
constexpr float QA_SCALE = 0.125f * LOG2E;
constexpr float QB_SCALE = 0.07216878364870322f * LOG2E;

constexpr size_t MiB = 1u << 20;
constexpr size_t WS_CTL = 0;
constexpr size_t ZERO_BYTES = 1 * MiB;
constexpr size_t WS_SSKR = 4 * MiB;
constexpr size_t WS_KRR = 5 * MiB;
constexpr size_t WS_ROPEC = 9 * MiB, WS_ROPES = 11 * MiB;
constexpr size_t WS_HB = 13 * MiB;
constexpr size_t WS_U = 77 * MiB;
constexpr size_t WS_QA = 253 * MiB, WS_KA = 285 * MiB, WS_VA = 293 * MiB, WS_CQ = 301 * MiB, WS_CKV = 317 * MiB;
constexpr size_t WS_QB = 325 * MiB, WS_KB = 373 * MiB, WS_VB = 421 * MiB, WS_O = 453 * MiB, WS_PP = 517 * MiB, WS_PB = 581 * MiB;
constexpr size_t WS_W = 613 * MiB;
constexpr size_t W_1GU = 0, W_1D = 22 * MiB, W_IN = 33 * MiB, W_UQ = 43 * MiB, W_UKV = 45 * MiB, W_O = 46 * MiB, W_2GU = 54 * MiB, W_2D = 76 * MiB, W_PG = 87 * MiB, W_PP = 95 * MiB, W_LAYER = 96 * MiB;
constexpr size_t WS_HB2 = WS_W + DEPTH * W_LAYER;
constexpr size_t WS_STATS = WS_HB2 + 64 * MiB;
constexpr size_t WS_QA8 = WS_STATS + 16 * MiB;
constexpr size_t WS_RSQ8 = WS_QA8 + 32 * MiB;
constexpr size_t WS_WSC = WS_RSQ8 + 1 * MiB;
constexpr size_t WS_QU8 = WS_WSC + 1 * MiB;
constexpr size_t WS_RSU = WS_QU8 + 88 * MiB;
constexpr size_t WS_WSCD = WS_RSU + 1 * MiB;
constexpr size_t WS_WSCP = WS_WSCD + 1 * MiB;
constexpr size_t WS_PP2 = WS_WSCP + 1 * MiB;
constexpr size_t WS_END = WS_PP2 + 64 * MiB;
static_assert((size_t)11264 * 2048 == 22 * MiB && (size_t)2048 * 5632 == 11 * MiB && (size_t)NIN * 2048 * 2 == 10 * MiB, "weight sizes");
enum { SS_IN = 0, SS_1 = 1, SS_CQ = 2, SS_CKV = 3, SS_2 = 4, SS_3 = 5, SS_PP = 6, SS_PP2 = 7 };
typedef __attribute__((address_space(4))) const unsigned long long* KArg;
constexpr int KA_OUT = 29, KA_WS = 30;
__device__ __forceinline__ KArg ka_fresh(KArg k) { asm volatile("" : "+s"(k)); return k; }
template <class T> __device__ __forceinline__ T* ka_ptr(KArg k, int i) { return (T*)(__attribute__((address_space(1))) T*)k[i]; }
__device__ __forceinline__ float* ka_stats(KArg k, int slot) { return (float*)(ka_ptr<unsigned char>(k, KA_WS) + WS_STATS) + (size_t)slot * MROWS * 32; }

namespace pg8 {
typedef float f32x2 __attribute__((ext_vector_type(2)));
typedef unsigned u32x2 __attribute__((ext_vector_type(2)));
__device__ __forceinline__ float rsq(float x) { return __builtin_amdgcn_rsqf(x); }
__device__ __forceinline__ float dot4(f32x4 a) { return (a[0] * a[0] + a[1] * a[1]) + (a[2] * a[2] + a[3] * a[3]); }
__device__ __forceinline__ u32x4 pack8(f32x4 a, f32x4 b) { u32x4 w; w.x = cvt_pk_bf16(a[0], a[1]); w.y = cvt_pk_bf16(a[2], a[3]); w.z = cvt_pk_bf16(b[0], b[1]); w.w = cvt_pk_bf16(b[2], b[3]); return w; }
__device__ __forceinline__ float silu1(float x) { return x * __builtin_amdgcn_rcpf(1.0f + __builtin_amdgcn_exp2f(-x * LOG2E)); }
__device__ __forceinline__ float sigm1(float x) { return __builtin_amdgcn_rcpf(1.0f + __builtin_amdgcn_exp2f(-x * LOG2E)); }
__device__ __forceinline__ float bf_lo(unsigned w) { return __uint_as_float(w << 16); }
__device__ __forceinline__ float bf_hi(unsigned w) { return __uint_as_float(w & 0xffff0000u); }
__device__ __forceinline__ float ssq32(const float* slot, int row, int fq) { const f32x4 a = *(const f32x4*)(slot + (size_t)row * 32 + fq * 8), b = *(const f32x4*)(slot + (size_t)row * 32 + fq * 8 + 4);
    float s = ((a[0] + a[1]) + (a[2] + a[3])) + ((b[0] + b[1]) + (b[2] + b[3])); s += __shfl_xor(s, 16); s += __shfl_xor(s, 32); return s; }
__device__ __forceinline__ float rowsum_fq(float s) { s += __shfl_xor(s, 16); s += __shfl_xor(s, 32); return s; }


struct EpiSwiGLU {
    static constexpr bool PERM = true, AFTER_DRAIN = false, WANTS_UI = false;
    KArg ka; int slot_in; const PG8_LAS float* rs_tab; bf16_t* Ubase;
    __device__ __forceinline__ void operator()(const f32x4 (&acc)[2][2][4][2], const Unit& u, int wr, int wc_, int fr_, int fq_) const {
        int fr = fr_, fq = fq_, wc = wc_; asm volatile("" : "+v"(fr), "+v"(fq), "+s"(wc));
        const int row0 = u.pm * BM + wr * 64 + fr, col0 = u.pn * 128 + wc * 32 + 8 * fq;
        bf16_t* U = Ubase; asm volatile("" : "+s"(U));
        const float* ssq = nullptr; if (!rs_tab) ssq = ka_stats(ka_fresh(ka), slot_in);
#pragma unroll
        for (int ai = 0; ai < 2; ++ai)
#pragma unroll
            for (int m = 0; m < 4; ++m) { const int row = row0 + ai * HALF + m * 16; const float rs = rs_tab ? rs_tab[ai * HALF + wr * 64 + m * 16 + fr] : rsq(ssq32(ssq, row, fq) * (1.0f / DM) + EPS);
                f32x4 o[2];
#pragma unroll
                for (int n = 0; n < 2; ++n) { const f32x4 g = acc[ai][0][m][n] * rs, up = acc[ai][1][m][n] * rs;
                    o[n] = (f32x4){silu1(g[0]) * up[0], silu1(g[1]) * up[1], silu1(g[2]) * up[2], silu1(g[3]) * up[3]}; }
                *(u32x4*)(U + (size_t)row * DFF + col0) = pack8(o[0], o[1]); }
    }
};
struct EpiSwiGLU8 {
    static constexpr bool PERM = true, AFTER_DRAIN = false, WANTS_UI = true;
    KArg ka; const PG8_LAS float* rs_tab; const PG8_LAS float* cs_tab; size_t wsc_off; bf16_t* Ubase;
    __device__ __forceinline__ void operator()(const f32x4 (&acc)[2][2][4][2], const Unit& u, int ui, int wr, int wc_, int fr_, int fq_) const {
        int fr = fr_, fq = fq_, wc = wc_; asm volatile("" : "+v"(fr), "+v"(fq), "+s"(wc));
        const int row0 = u.pm * BM + wr * 64 + fr, col0 = u.pn * 128 + wc * 32 + 8 * fq;
        bf16_t* U = Ubase; asm volatile("" : "+s"(U));
        f32x4 cs[2][2];
        if (cs_tab) {
#pragma unroll
            for (int bj = 0; bj < 2; ++bj)
#pragma unroll
                for (int n = 0; n < 2; ++n) cs[bj][n] = *(const PG8_LAS f32x4*)(cs_tab + ui * 256 + bj * 128 + wc * 32 + 8 * fq + 4 * n);
        } else { const float* w = (const float*)(ka_ptr<unsigned char>(ka_fresh(ka), KA_WS) + wsc_off) + (size_t)u.pn * 256;
#pragma unroll
            for (int bj = 0; bj < 2; ++bj)
#pragma unroll
                for (int n = 0; n < 2; ++n) cs[bj][n] = *(const f32x4*)(w + bj * 128 + wc * 32 + 8 * fq + 4 * n); }
        const float* rsg = nullptr; if (!rs_tab) rsg = (const float*)(ka_ptr<unsigned char>(ka_fresh(ka), KA_WS) + WS_RSQ8);
#pragma unroll
        for (int ai = 0; ai < 2; ++ai)
#pragma unroll
            for (int m = 0; m < 4; ++m) { const int row = row0 + ai * HALF + m * 16; const float rs = rs_tab ? rs_tab[ai * HALF + wr * 64 + m * 16 + fr] : rsg[row];
                f32x4 o[2];
#pragma unroll
                for (int n = 0; n < 2; ++n) { const i32x4 gi = __builtin_bit_cast(i32x4, acc[ai][0][m][n]), vi = __builtin_bit_cast(i32x4, acc[ai][1][m][n]);
                    const f32x4 gf = (f32x4){(float)gi[0], (float)gi[1], (float)gi[2], (float)gi[3]}, sg = cs[0][n] * rs;
                    const f32x4 g = gf * sg, t = gf * (sg * -LOG2E), up = (f32x4){(float)vi[0], (float)vi[1], (float)vi[2], (float)vi[3]} * (cs[1][n] * rs), gu = g * up;
                    o[n] = (f32x4){gu[0] * __builtin_amdgcn_rcpf(1.0f + __builtin_amdgcn_exp2f(t[0])), gu[1] * __builtin_amdgcn_rcpf(1.0f + __builtin_amdgcn_exp2f(t[1])),
                                   gu[2] * __builtin_amdgcn_rcpf(1.0f + __builtin_amdgcn_exp2f(t[2])), gu[3] * __builtin_amdgcn_rcpf(1.0f + __builtin_amdgcn_exp2f(t[3]))}; }
                *(u32x4*)(U + (size_t)row * DFF + col0) = pack8(o[0], o[1]); }
    }
};
struct EpiResid {
    static constexpr bool PERM = true, AFTER_DRAIN = false, WANTS_UI = false;
    KArg ka; int slot_out; float scale; size_t src_off, dst_off;
    __device__ __forceinline__ void operator()(const f32x4 (&acc)[2][2][4][2], const Unit& u, int wr, int wc_, int fr_, int fq_) const {
        int fr = fr_, fq = fq_, wc = wc_; asm volatile("" : "+v"(fr), "+v"(fq), "+s"(wc));
        const int row0 = u.pm * BM + wr * 64 + fr, col0 = u.pn * BM + wc * 32 + 8 * fq;
        const KArg k = ka_fresh(ka); const bf16_t* XS = (const bf16_t*)(ka_ptr<unsigned char>(k, KA_WS) + src_off); bf16_t* XD = (bf16_t*)(ka_ptr<unsigned char>(k, KA_WS) + dst_off); float* ssq_out = ka_stats(k, slot_out);
#pragma unroll
        for (int ai = 0; ai < 2; ++ai) {
            u32x4 xin[4][2];
#pragma unroll
            for (int m = 0; m < 4; ++m)
#pragma unroll
                for (int bj = 0; bj < 2; ++bj) xin[m][bj] = *(const u32x4*)(XS + (size_t)(row0 + ai * HALF + m * 16) * DM + col0 + bj * HALF);
            asm volatile("s_waitcnt vmcnt(0)" ::: "memory");
#pragma unroll
            for (int m = 0; m < 4; ++m) { const int row = row0 + ai * HALF + m * 16; float part = 0.f;
#pragma unroll
                for (int bj = 0; bj < 2; ++bj) { const size_t off = (size_t)row * DM + col0 + bj * HALF; const u32x4 xw = xin[m][bj];
                    f32x4 x0 = (f32x4){bf_lo(xw.x), bf_hi(xw.x), bf_lo(xw.y), bf_hi(xw.y)}, x1 = (f32x4){bf_lo(xw.z), bf_hi(xw.z), bf_lo(xw.w), bf_hi(xw.w)};
                    x0 = x0 + acc[ai][bj][m][0] * scale; x1 = x1 + acc[ai][bj][m][1] * scale;
                    *(u32x4*)(XD + off) = pack8(x0, x1);
                    part += dot4(x0) + dot4(x1); }
                if (slot_out >= 0) { part = rowsum_fq(part); if (fq == 0) ssq_out[(size_t)row * 32 + u.pn * 4 + wc] = part; } } }
    }
};
struct EpiResid8 {
    static constexpr bool PERM = true, AFTER_DRAIN = false, WANTS_UI = false;
    KArg ka; int slot_out; float scale; size_t src_off, dst_off, wsc_off;
    __device__ __forceinline__ void operator()(const f32x4 (&acc)[2][2][4][2], const Unit& u, int wr, int wc_, int fr_, int fq_) const {
        int fr = fr_, fq = fq_, wc = wc_; asm volatile("" : "+v"(fr), "+v"(fq), "+s"(wc));
        const int row0 = u.pm * BM + wr * 64 + fr, col0 = u.pn * BM + wc * 32 + 8 * fq;
        const KArg k = ka_fresh(ka); const bf16_t* XS = (const bf16_t*)(ka_ptr<unsigned char>(k, KA_WS) + src_off); bf16_t* XD = (bf16_t*)(ka_ptr<unsigned char>(k, KA_WS) + dst_off); float* ssq_out = ka_stats(k, slot_out);
        const float* rsu = (const float*)(ka_ptr<unsigned char>(k, KA_WS) + WS_RSU); const float* wsc = (const float*)(ka_ptr<unsigned char>(k, KA_WS) + wsc_off);
        f32x4 cs[2][2];
#pragma unroll
        for (int bj = 0; bj < 2; ++bj)
#pragma unroll
            for (int n = 0; n < 2; ++n) cs[bj][n] = *(const f32x4*)(wsc + col0 + bj * HALF + 4 * n);
#pragma unroll
        for (int ai = 0; ai < 2; ++ai) {
            u32x4 xin[4][2]; float rs[4];
#pragma unroll
            for (int m = 0; m < 4; ++m) { rs[m] = rsu[row0 + ai * HALF + m * 16];
#pragma unroll
                for (int bj = 0; bj < 2; ++bj) xin[m][bj] = *(const u32x4*)(XS + (size_t)(row0 + ai * HALF + m * 16) * DM + col0 + bj * HALF); }
            asm volatile("s_waitcnt vmcnt(0)" ::: "memory");
#pragma unroll
            for (int m = 0; m < 4; ++m) { const int row = row0 + ai * HALF + m * 16; float part = 0.f; const float rsc = rs[m] * scale;
#pragma unroll
                for (int bj = 0; bj < 2; ++bj) { const size_t off = (size_t)row * DM + col0 + bj * HALF; const u32x4 xw = xin[m][bj];
                    f32x4 x0 = (f32x4){bf_lo(xw.x), bf_hi(xw.x), bf_lo(xw.y), bf_hi(xw.y)}, x1 = (f32x4){bf_lo(xw.z), bf_hi(xw.z), bf_lo(xw.w), bf_hi(xw.w)};
                    const i32x4 a0 = __builtin_bit_cast(i32x4, acc[ai][bj][m][0]), a1 = __builtin_bit_cast(i32x4, acc[ai][bj][m][1]);
                    x0 = x0 + (f32x4){(float)a0[0], (float)a0[1], (float)a0[2], (float)a0[3]} * (cs[bj][0] * rsc); x1 = x1 + (f32x4){(float)a1[0], (float)a1[1], (float)a1[2], (float)a1[3]} * (cs[bj][1] * rsc);
                    *(u32x4*)(XD + off) = pack8(x0, x1);
                    part += dot4(x0) + dot4(x1); }
                if (slot_out >= 0) { part = rowsum_fq(part); if (fq == 0) ssq_out[(size_t)row * 32 + u.pn * 4 + wc] = part; } } }
    }
};
struct EpiStoreSsq {
    static constexpr bool PERM = true, AFTER_DRAIN = false, WANTS_UI = false;
    KArg ka; int slot_out; size_t out_off;
    __device__ __forceinline__ void operator()(const f32x4 (&acc)[2][2][4][2], const Unit& u, int wr, int wc_, int fr_, int fq_) const {
        int fr = fr_, fq = fq_, wc = wc_; asm volatile("" : "+v"(fr), "+v"(fq), "+s"(wc));
        const int row0 = u.pm * BM + wr * 64 + fr, col0 = u.pn * BM + wc * 32 + 8 * fq;
        const KArg k = ka_fresh(ka); bf16_t* O = (bf16_t*)(ka_ptr<unsigned char>(k, KA_WS) + out_off); constexpr int ldc = DM; float* ssq_out = ka_stats(k, slot_out);
#pragma unroll
        for (int ai = 0; ai < 2; ++ai)
#pragma unroll
            for (int m = 0; m < 4; ++m) { const int row = row0 + ai * HALF + m * 16; float part = 0.f;
#pragma unroll
                for (int bj = 0; bj < 2; ++bj) { const f32x4 v0 = acc[ai][bj][m][0], v1 = acc[ai][bj][m][1];
                    *(u32x4*)(O + (size_t)row * ldc + col0 + bj * HALF) = pack8(v0, v1); part += dot4(v0) + dot4(v1); }
                part = rowsum_fq(part);
                if (fq == 0) ssq_out[(size_t)row * 32 + u.pn * 4 + wc] = part; }
    }
};
struct EpiWin {
    static constexpr bool PERM = true, AFTER_DRAIN = false, WANTS_UI = false;
    KArg ka; int l; const PG8_LAS float* rs_tab;
    __device__ __forceinline__ void operator()(const f32x4 (&acc)[2][2][4][2], const Unit& u, int wr, int wc_, int fr_, int fq_) const {
        int fr = fr_, fq = fq_, wc = wc_; asm volatile("" : "+v"(fr), "+v"(fq), "+s"(wc));
        const int row0 = u.pm * BM + wr * 64 + fr, pn = u.pn;
        const KArg k = ka_fresh(ka); unsigned char* ws = ka_ptr<unsigned char>(k, KA_WS); const float* ssq_in = ka_stats(k, SS_1);
        if (pn <= 4) {
            const float* gq = ka_ptr<const float>(k, 9) + l * 64; const float* gk = ka_ptr<const float>(k, 10) + l * 64; bf16_t* QA = (bf16_t*)(ws + WS_QA); bf16_t* KA = (bf16_t*)(ws + WS_KA);
            const float* gain = pn < 4 ? gq : gk; const float extra = pn < 4 ? QA_SCALE : 1.0f;
            bf16_t* dst = pn < 4 ? QA + (4 * pn + wc) * 64 : KA + wc * 64; const int pitch = pn < 4 ? QA_PITCH : KA_PITCH;
            f32x4 g[2][2];
#pragma unroll
            for (int bj = 0; bj < 2; ++bj)
#pragma unroll
                for (int n = 0; n < 2; ++n) g[bj][n] = *(const f32x4*)(gain + 32 * bj + 8 * fq + 4 * n);
#pragma unroll
            for (int ai = 0; ai < 2; ++ai)
#pragma unroll
                for (int m = 0; m < 4; ++m) { const int row = row0 + ai * HALF + m * 16; const float rs = rs_tab ? rs_tab[ai * HALF + wr * 64 + m * 16 + fr] : rsq(ssq32(ssq_in, row, fq) * (1.0f / DM) + EPS);
                    float ss = 0.f;
#pragma unroll
                    for (int bj = 0; bj < 2; ++bj)
#pragma unroll
                        for (int n = 0; n < 2; ++n) ss += dot4(acc[ai][bj][m][n]);
                    ss = rowsum_fq(ss) * rs * rs;
                    const float sc = rsq(ss * (1.0f / 64.0f) + EPS) * extra * rs;
#pragma unroll
                    for (int bj = 0; bj < 2; ++bj)
                        *(u32x4*)(dst + (size_t)row * pitch + 32 * bj + 8 * fq) = pack8(acc[ai][bj][m][0] * sc * g[bj][0], acc[ai][bj][m][1] * sc * g[bj][1]); }
        } else if (pn <= 8) {
            bf16_t* dst; int pitch; float* sq; bf16_t* VA = (bf16_t*)(ws + WS_VA); bf16_t* CQ = (bf16_t*)(ws + WS_CQ); bf16_t* CKV = (bf16_t*)(ws + WS_CKV);
            float* ssq_cq = ka_stats(k, SS_CQ); float* ssq_ckv = ka_stats(k, SS_CKV);
            if (pn == 5) { dst = VA; pitch = VA_PITCH; sq = nullptr; } else if (pn <= 7) { dst = CQ + (pn - 6) * 256; pitch = 512; sq = ssq_cq; } else { dst = CKV; pitch = 256; sq = ssq_ckv; }
#pragma unroll
            for (int ai = 0; ai < 2; ++ai)
#pragma unroll
                for (int m = 0; m < 4; ++m) { const int row = row0 + ai * HALF + m * 16; const float rs = rs_tab ? rs_tab[ai * HALF + wr * 64 + m * 16 + fr] : rsq(ssq32(ssq_in, row, fq) * (1.0f / DM) + EPS); float part = 0.f;
#pragma unroll
                    for (int bj = 0; bj < 2; ++bj) { const f32x4 v0 = acc[ai][bj][m][0] * rs, v1 = acc[ai][bj][m][1] * rs;
                        *(u32x4*)(dst + (size_t)row * pitch + bj * HALF + wc * 32 + 8 * fq) = pack8(v0, v1); part += dot4(v0) + dot4(v1); }
                    part = rowsum_fq(part);
                    if (sq != nullptr && fq == 0) sq[(size_t)row * 32 + (pn == 7 ? 4 : 0) + wc] = part; }
        } else if (wc == 0) {
            const float* gkr = ka_ptr<const float>(k, 17) + l * 192 + 128; float* SSKR = (float*)(ws + WS_SSKR); float* KRR = (float*)(ws + WS_KRR);
            const float* ropec = (const float*)(ws + WS_ROPEC); const float* ropes = (const float*)(ws + WS_ROPES);
            f32x4 g1[2], g2[2];
#pragma unroll
            for (int n = 0; n < 2; ++n) { g1[n] = *(const f32x4*)(gkr + 8 * fq + 4 * n); g2[n] = *(const f32x4*)(gkr + 32 + 8 * fq + 4 * n); }
#pragma unroll
            for (int am = 0; am < 4; ++am) { const int ai = am >> 1, m0 = 2 * (am & 1);
                f32x4 cs[2][2], sn[2][2];
#pragma unroll
                for (int mm = 0; mm < 2; ++mm)
#pragma unroll
                    for (int n = 0; n < 2; ++n) { const size_t ro = (size_t)(row0 + ai * HALF + (m0 + mm) * 16) * 32 + 8 * fq + 4 * n; cs[mm][n] = *(const f32x4*)(ropec + ro); sn[mm][n] = *(const f32x4*)(ropes + ro); }
                asm volatile("s_waitcnt vmcnt(0)" ::: "memory");
#pragma unroll
                for (int mm = 0; mm < 2; ++mm) { const int m = m0 + mm, row = row0 + ai * HALF + m * 16; const float rs = rs_tab ? rs_tab[ai * HALF + wr * 64 + m * 16 + fr] : rsq(ssq32(ssq_in, row, fq) * (1.0f / DM) + EPS);
                    float ss = 0.f;
#pragma unroll
                    for (int bj = 0; bj < 2; ++bj)
#pragma unroll
                        for (int n = 0; n < 2; ++n) ss += dot4(acc[ai][bj][m][n]);
                    ss = rowsum_fq(ss) * rs * rs;
                    if (fq == 0) SSKR[row] = ss;
#pragma unroll
                    for (int n = 0; n < 2; ++n) { const f32x4 c = cs[mm][n], s = sn[mm][n];
                        const f32x4 x1 = acc[ai][0][m][n] * rs * g1[n], x2 = acc[ai][1][m][n] * rs * g2[n];
                        *(f32x4*)(KRR + (size_t)row * 64 + 8 * fq + 4 * n) = x1 * c - x2 * s;
                        *(f32x4*)(KRR + (size_t)row * 64 + 32 + 8 * fq + 4 * n) = x2 * c + x1 * s; } } }
        }
    }
};
struct EpiQB {
    static constexpr bool PERM = true, AFTER_DRAIN = false, WANTS_UI = false;
    KArg ka; int l; PG8_LAS float* T;
    __device__ __forceinline__ void operator()(const f32x4 (&acc)[2][2][4][2], const Unit& u, int wr, int wc_, int fr_, int fq_) const {
        int fr = fr_, fq = fq_, wc = wc_; asm volatile("" : "+v"(fr), "+v"(fq), "+s"(wc));
        const int row0 = u.pm * BM + wr * 64 + fr, h = u.pn;
        const KArg k = ka_fresh(ka); unsigned char* ws = ka_ptr<unsigned char>(k, KA_WS); const float* ssq_cq = ka_stats(k, SS_CQ); const float* gqn = ka_ptr<const float>(k, 16) + l * 192;
        bf16_t* QB = (bf16_t*)(ws + WS_QB); const float* ropec = (const float*)(ws + WS_ROPEC); const float* ropes = (const float*)(ws + WS_ROPES);
        float rs[2][4]; f32x2 sq[2][4]; f32x4 g[2][2];
#pragma unroll
        for (int ai = 0; ai < 2; ++ai)
#pragma unroll
            for (int m = 0; m < 4; ++m) sq[ai][m] = *(const f32x2*)(ssq_cq + (size_t)(row0 + ai * HALF + m * 16) * 32 + 2 * fq);
        if (wc < 3) {
#pragma unroll
            for (int bj = 0; bj < 2; ++bj)
#pragma unroll
                for (int n = 0; n < 2; ++n) g[bj][n] = *(const f32x4*)(gqn + 64 * wc + 32 * bj + 8 * fq + 4 * n);
        }
#pragma unroll
        for (int ai = 0; ai < 2; ++ai)
#pragma unroll
            for (int m = 0; m < 4; ++m) { rs[ai][m] = rsq(rowsum_fq(sq[ai][m][0] + sq[ai][m][1]) * (1.0f / 512.0f) + EPS);
                float ss = 0.f;
#pragma unroll
                for (int bj = 0; bj < 2; ++bj)
#pragma unroll
                    for (int n = 0; n < 2; ++n) ss += dot4(acc[ai][bj][m][n]);
                ss = rowsum_fq(ss) * rs[ai][m] * rs[ai][m];
                if (fq == 0) T[(ai * HALF + wr * 64 + m * 16 + fr) * 4 + wc] = ss; }
        asm volatile("s_waitcnt lgkmcnt(0)" ::: "memory"); __builtin_amdgcn_s_barrier(); asm volatile("" ::: "memory");
        if (wc < 3) {
#pragma unroll
            for (int ai = 0; ai < 2; ++ai)
#pragma unroll
                for (int m = 0; m < 4; ++m) { const int row = row0 + ai * HALF + m * 16; const f32x4 t = *(const PG8_LAS f32x4*)(T + (ai * HALF + wr * 64 + m * 16 + fr) * 4);
                    const float sc = rsq(((t[0] + t[1]) + (t[2] + t[3])) * (1.0f / 192.0f) + EPS) * QB_SCALE * rs[ai][m];
#pragma unroll
                    for (int bj = 0; bj < 2; ++bj)
                        *(u32x4*)(QB + (size_t)row * QB_PITCH + h * 192 + 64 * wc + 32 * bj + 8 * fq) = pack8(acc[ai][bj][m][0] * sc * g[bj][0], acc[ai][bj][m][1] * sc * g[bj][1]); }
        }
    }
};
struct EpiKV {
    static constexpr bool PERM = true, AFTER_DRAIN = false, WANTS_UI = false;
    KArg ka; int l; PG8_LAS float* T;
    __device__ __forceinline__ void operator()(const f32x4 (&acc)[2][2][4][2], const Unit& u, int wr, int wc_, int fr_, int fq_) const {
        int fr = fr_, fq = fq_, wc = wc_; asm volatile("" : "+v"(fr), "+v"(fq), "+s"(wc));
        const int row0 = u.pm * BM + wr * 64 + fr, h = u.pn;
        const KArg k = ka_fresh(ka); unsigned char* ws = ka_ptr<unsigned char>(k, KA_WS); const float* ssq_ckv = ka_stats(k, SS_CKV); const float* gkn = ka_ptr<const float>(k, 17) + l * 192;
        bf16_t* KB = (bf16_t*)(ws + WS_KB); bf16_t* VB = (bf16_t*)(ws + WS_VB); const float* SSKR = (const float*)(ws + WS_SSKR); const float* KRR = (const float*)(ws + WS_KRR);
        float rs[2][4], skr[2][4]; f32x4 krv[2][4], g[2];
#pragma unroll
        for (int n = 0; n < 2; ++n) g[n] = *(const f32x4*)(gkn + 32 * wc + 8 * fq + 4 * n);
#pragma unroll
        for (int ai = 0; ai < 2; ++ai)
#pragma unroll
            for (int m = 0; m < 4; ++m) { const int row = row0 + ai * HALF + m * 16; skr[ai][m] = SSKR[row]; krv[ai][m] = *(const f32x4*)(KRR + (size_t)row * 64 + 16 * wc + 4 * fq); }
#pragma unroll
        for (int ai = 0; ai < 2; ++ai)
#pragma unroll
            for (int m = 0; m < 4; ++m) { const int row = row0 + ai * HALF + m * 16; { const f32x4 a_ = *(const f32x4*)(ssq_ckv + (size_t)row * 32); rs[ai][m] = rsq(((a_[0] + a_[1]) + (a_[2] + a_[3])) * (1.0f / 256.0f) + EPS); }
                float ss = dot4(acc[ai][0][m][0]) + dot4(acc[ai][0][m][1]);
                ss = rowsum_fq(ss) * rs[ai][m] * rs[ai][m];
                if (fq == 0) T[(ai * HALF + wr * 64 + m * 16 + fr) * 4 + wc] = ss; }
        asm volatile("s_waitcnt lgkmcnt(0)" ::: "memory"); __builtin_amdgcn_s_barrier(); asm volatile("" ::: "memory");
#pragma unroll
        for (int ai = 0; ai < 2; ++ai)
#pragma unroll
            for (int m = 0; m < 4; ++m) { const int row = row0 + ai * HALF + m * 16; const f32x4 t = *(const PG8_LAS f32x4*)(T + (ai * HALF + wr * 64 + m * 16 + fr) * 4);
                const float sh = rsq((((t[0] + t[1]) + (t[2] + t[3])) + skr[ai][m]) * (1.0f / 192.0f) + EPS), sc = sh * rs[ai][m];
                *(u32x4*)(KB + (size_t)row * KB_PITCH + h * 192 + 32 * wc + 8 * fq) = pack8(acc[ai][0][m][0] * sc * g[0], acc[ai][0][m][1] * sc * g[1]);
                *(u32x4*)(VB + (size_t)row * VB_PITCH + h * 128 + 32 * wc + 8 * fq) = pack8(acc[ai][1][m][0] * rs[ai][m], acc[ai][1][m][1] * rs[ai][m]);
                const f32x4 kr = krv[ai][m] * sh;
                u32x2 w; w.x = cvt_pk_bf16(kr[0], kr[1]); w.y = cvt_pk_bf16(kr[2], kr[3]);
                *(u32x2*)(KB + (size_t)row * KB_PITCH + h * 192 + 128 + 16 * wc + 4 * fq) = w; }
    }
};
struct EpiPle {
    static constexpr bool PERM = true, AFTER_DRAIN = false, WANTS_UI = false;
    KArg ka; int l; const PG8_LAS float* rs_tab; size_t wsc_off, pp_off; int pp_slot;
    __device__ __forceinline__ void operator()(const f32x4 (&acc)[2][2][4][2], const Unit& u, int wr, int wc_, int fr_, int fq_) const {
        int fr = fr_, fq = fq_, wc = wc_; asm volatile("" : "+v"(fr), "+v"(fq), "+s"(wc));
        const int row0 = u.pm * BM + wr * 64 + fr, col0 = u.pn * BM + wc * 32 + 8 * fq;
        const KArg k = ka_fresh(ka); unsigned char* ws = ka_ptr<unsigned char>(k, KA_WS); float* OUT = ka_ptr<float>(k, KA_OUT); const bf16_t* XS = (const bf16_t*)(ws + WS_HB); bf16_t* XD = (bf16_t*)(ws + WS_HB2); const bf16_t* PP = (const bf16_t*)(ws + pp_off);
        const float* rsq8 = (const float*)(ws + WS_RSQ8); const float* wsc = (const float*)(ws + wsc_off); const float* ssq_pp = ka_stats(k, pp_slot); const float* gpp = ka_ptr<const float>(k, 26) + l * DM;
        f32x4 g[2][2], cw[2][2];
#pragma unroll
        for (int bj = 0; bj < 2; ++bj)
#pragma unroll
            for (int n = 0; n < 2; ++n) { g[bj][n] = *(const f32x4*)(gpp + col0 + bj * HALF + 4 * n); cw[bj][n] = *(const f32x4*)(wsc + col0 + bj * HALF + 4 * n); }
#pragma unroll
        for (int am = 0; am < 4; ++am) { const int ai = am >> 1, m0 = 2 * (am & 1);
            u32x4 xin[2][2], pin[2][2];
#pragma unroll
            for (int mm = 0; mm < 2; ++mm)
#pragma unroll
                for (int bj = 0; bj < 2; ++bj) { const size_t off = (size_t)(row0 + ai * HALF + (m0 + mm) * 16) * DM + col0 + bj * HALF; xin[mm][bj] = *(const u32x4*)(XS + off); pin[mm][bj] = *(const u32x4*)(PP + off); }
            asm volatile("s_waitcnt vmcnt(0)" ::: "memory");
#pragma unroll
            for (int mm = 0; mm < 2; ++mm) { const int m = m0 + mm, row = row0 + ai * HALF + m * 16; const int rl = ai * HALF + wr * 64 + m * 16 + fr; const float rs = rs_tab ? rs_tab[rl] : rsq8[row], rp = rs_tab ? rs_tab[256 + rl] : rsq(ssq32(ssq_pp, row, fq) * (1.0f / DM) + EPS);
#pragma unroll
                for (int bj = 0; bj < 2; ++bj) { const size_t off = (size_t)row * DM + col0 + bj * HALF; const u32x4 xw = xin[mm][bj];
                    f32x4 x0 = (f32x4){bf_lo(xw.x), bf_hi(xw.x), bf_lo(xw.y), bf_hi(xw.y)}, x1 = (f32x4){bf_lo(xw.z), bf_hi(xw.z), bf_lo(xw.w), bf_hi(xw.w)};
                    const u32x4 pw = pin[mm][bj];
                    const f32x4 p0 = (f32x4){bf_lo(pw.x), bf_hi(pw.x), bf_lo(pw.y), bf_hi(pw.y)}, p1 = (f32x4){bf_lo(pw.z), bf_hi(pw.z), bf_lo(pw.w), bf_hi(pw.w)};
                    const i32x4 i0 = __builtin_bit_cast(i32x4, acc[ai][bj][m][0]), i1 = __builtin_bit_cast(i32x4, acc[ai][bj][m][1]);
                    const f32x4 a0 = (f32x4){(float)i0[0], (float)i0[1], (float)i0[2], (float)i0[3]} * (cw[bj][0] * rs), a1 = (f32x4){(float)i1[0], (float)i1[1], (float)i1[2], (float)i1[3]} * (cw[bj][1] * rs);
                    const f32x4 s0 = (f32x4){sigm1(a0[0]), sigm1(a0[1]), sigm1(a0[2]), sigm1(a0[3])}, s1 = (f32x4){sigm1(a1[0]), sigm1(a1[1]), sigm1(a1[2]), sigm1(a1[3])};
                    x0 = x0 + p0 * rp * g[bj][0] * s0; x1 = x1 + p1 * rp * g[bj][1] * s1;
                    if (l == DEPTH - 1) { *(f32x4*)(OUT + off) = x0; *(f32x4*)(OUT + off + 4) = x1; }
                    else *(u32x4*)(XD + off) = pack8(x0, x1); }
            } }
    }
};
}
namespace att {
typedef short bf16x8 __attribute__((ext_vector_type(8)));
typedef short s16x4 __attribute__((ext_vector_type(4)));
typedef float f32x16 __attribute__((ext_vector_type(16)));
typedef float f32x4 __attribute__((ext_vector_type(4)));
typedef unsigned u32x4 __attribute__((ext_vector_type(4)));
typedef int i32x4 __attribute__((ext_vector_type(4)));
typedef __attribute__((address_space(3))) char* lptr;
#define ATT_LAS __attribute__((address_space(3)))
#define ATT_SBAR() __builtin_amdgcn_sched_barrier(0)
constexpr int KROW_MLA = 400, KT_MLA = 64 * KROW_MLA, VT_MLA = 64 * 128 * 2;
constexpr int KROW_SWA = 144, KT_SWA = 64 * KROW_SWA, VT_SWA = 64 * 64 * 2;
constexpr int MLA_K = 0, MLA_V = 2 * KT_MLA;
constexpr int SWA_K = 0, SWA_V = 4 * KT_SWA, SWA_POS = SWA_V + 4 * VT_SWA;
constexpr int LDS_SCR = 90112;
constexpr int ATT_LDS_BYTES = LDS_SCR + 8 * 64 * 4;

__device__ __forceinline__ int crow(int r, int hi) { return (r & 3) + 8 * (r >> 2) + 4 * hi; }
__device__ __forceinline__ unsigned cvtpk(float lo, float hi) { return pg8::cvt_pk_bf16(lo, hi); }
template <int NCB> __device__ __forceinline__ int v_st(int k, int c) { const int kk = (k & ~0xC) | ((k & 4) << 1) | ((k & 8) >> 1); return ((kk >> 3) * NCB + (c >> 5)) * 512 + ((kk & 7) * 32 + (c & 31)) * 2; }
__device__ __forceinline__ int v_rd_base(int lane) { return ((lane & 3) << 3) | (((lane >> 2) & 3) << 6) | (((lane >> 4) & 1) << 5) | (((lane >> 5) & 1) << 8); }

__device__ __forceinline__ void mask_tile(f32x16& p0, f32x16& p1, int dq, unsigned W) {
    const float NEG = -__builtin_inff();
#pragma unroll
    for (int r = 0; r < 16; ++r) { const int c = (r & 3) + 8 * (r >> 2);
        if ((unsigned)(dq - c) >= W) p0[r] = NEG;
        if ((unsigned)(dq - c - 32) >= W) p1[r] = NEG; }
}
template <int ND0, int KROW> __device__ __forceinline__ void qkt(f32x16& p0, f32x16& p1, lptr kt, int r32, int hi, const bf16x8* qr) {
    p0 = f32x16{}; p1 = f32x16{};
    const lptr a = kt + r32 * KROW + hi * 16;
#pragma unroll
    for (int d0 = 0; d0 < ND0; ++d0) {
        const bf16x8 b0 = *(const ATT_LAS bf16x8*)(a + d0 * 32);
        const bf16x8 b1 = *(const ATT_LAS bf16x8*)(a + 32 * KROW + d0 * 32);
        p0 = __builtin_amdgcn_mfma_f32_32x32x16_bf16(b0, qr[d0], p0, 0, 0, 0);
        p1 = __builtin_amdgcn_mfma_f32_32x32x16_bf16(b1, qr[d0], p1, 0, 0, 0); }
}
template <int THR> __device__ __forceinline__ void softmax_tile(f32x16& p0, f32x16& p1, float& m_reg, float& l_reg, float& alpha, bf16x8& pa0, bf16x8& pa1, bf16x8& pa2, bf16x8& pa3) {
    float pmax = p0[0];
#pragma unroll
    for (int r = 1; r < 16; ++r) pmax = fmaxf(pmax, p0[r]);
#pragma unroll
    for (int r = 0; r < 16; ++r) pmax = fmaxf(pmax, p1[r]);
    { auto rr = __builtin_amdgcn_permlane32_swap(__float_as_uint(pmax), __float_as_uint(pmax), false, false); pmax = fmaxf(__uint_as_float(rr[0]), __uint_as_float(rr[1])); }
    float mn;
    if (THR > 0 && __all(pmax - m_reg <= (float)THR)) { mn = m_reg; alpha = 1.f; }
    else { mn = fmaxf(m_reg, pmax); alpha = __builtin_amdgcn_exp2f(m_reg - mn); m_reg = mn; }
    float ps = 0.f;
#pragma unroll
    for (int r = 0; r < 16; ++r) { p0[r] = __builtin_amdgcn_exp2f(p0[r] - mn); ps += p0[r]; }
#pragma unroll
    for (int r = 0; r < 16; ++r) { p1[r] = __builtin_amdgcn_exp2f(p1[r] - mn); ps += p1[r]; }
    { auto rr = __builtin_amdgcn_permlane32_swap(__float_as_uint(ps), __float_as_uint(ps), false, false); ps = __uint_as_float(rr[0]) + __uint_as_float(rr[1]); }
    l_reg = l_reg * alpha + ps;
#define ATT_PK4(P, B_, OUT) do { unsigned a0 = cvtpk(P[B_+0], P[B_+1]), a1 = cvtpk(P[B_+2], P[B_+3]); unsigned b0 = cvtpk(P[B_+4], P[B_+5]), b1 = cvtpk(P[B_+6], P[B_+7]); \
        auto r0 = __builtin_amdgcn_permlane32_swap(a0, b0, false, false); auto r1 = __builtin_amdgcn_permlane32_swap(a1, b1, false, false); \
        u32x4 w = {r0[0], r1[0], r0[1], r1[1]}; OUT = __builtin_bit_cast(bf16x8, w); } while (0)
    ATT_PK4(p0, 0, pa0); ATT_PK4(p0, 8, pa1); ATT_PK4(p1, 0, pa2); ATT_PK4(p1, 8, pa3);
#undef ATT_PK4
}
template <int THR> __device__ __forceinline__ void partial_sm(f32x16& p0, f32x16& p1, float& m_reg, float& alpha) {
    float pmax = p0[0];
#pragma unroll
    for (int r = 1; r < 16; ++r) pmax = fmaxf(pmax, p0[r]);
#pragma unroll
    for (int r = 0; r < 16; ++r) pmax = fmaxf(pmax, p1[r]);
    { auto rr = __builtin_amdgcn_permlane32_swap(__float_as_uint(pmax), __float_as_uint(pmax), false, false); pmax = fmaxf(__uint_as_float(rr[0]), __uint_as_float(rr[1])); }
    float mn;
    if (THR > 0 && __all(pmax - m_reg <= (float)THR)) { mn = m_reg; alpha = 1.f; }
    else { mn = fmaxf(m_reg, pmax); alpha = __builtin_amdgcn_exp2f(m_reg - mn); m_reg = mn; }
#pragma unroll
    for (int r = 0; r < 16; ++r) { p0[r] = __builtin_amdgcn_exp2f(p0[r] - mn); p1[r] = p1[r] - mn; }
}
__device__ __forceinline__ void finish_sm(f32x16& p0, f32x16& p1, float alpha, float& l_reg, bf16x8& pa0, bf16x8& pa1, bf16x8& pa2, bf16x8& pa3) {
    float ps = 0.f;
#pragma unroll
    for (int r = 0; r < 16; ++r) { p1[r] = __builtin_amdgcn_exp2f(p1[r]); ps += p0[r]; }
#pragma unroll
    for (int r = 0; r < 16; ++r) ps += p1[r];
    { auto rr = __builtin_amdgcn_permlane32_swap(__float_as_uint(ps), __float_as_uint(ps), false, false); ps = __uint_as_float(rr[0]) + __uint_as_float(rr[1]); }
    l_reg = l_reg * alpha + ps;
#define ATT_PK4(P, B_, OUT) do { unsigned a0 = cvtpk(P[B_+0], P[B_+1]), a1 = cvtpk(P[B_+2], P[B_+3]); unsigned b0 = cvtpk(P[B_+4], P[B_+5]), b1 = cvtpk(P[B_+6], P[B_+7]); \
        auto r0 = __builtin_amdgcn_permlane32_swap(a0, b0, false, false); auto r1 = __builtin_amdgcn_permlane32_swap(a1, b1, false, false); \
        u32x4 w = {r0[0], r1[0], r0[1], r1[1]}; OUT = __builtin_bit_cast(bf16x8, w); } while (0)
    ATT_PK4(p0, 0, pa0); ATT_PK4(p0, 8, pa1); ATT_PK4(p1, 0, pa2); ATT_PK4(p1, 8, pa3);
#undef ATT_PK4
}
#define ATT_TRRD(dst, off) asm volatile("ds_read_b64_tr_b16 %0, %1 offset:%2" : "=&v"(dst) : "v"(vb), "i"(off) : "memory")
#define ATT_PV_D0(NCB, d0) do { s16x4 l0, l1, l2, l3, h0, h1, h2, h3; constexpr int b_ = (d0) * 512, ks_ = (NCB) * 1024, hf_ = (NCB) * 512; \
        ATT_TRRD(l0, b_); ATT_TRRD(h0, b_ + hf_); ATT_TRRD(l1, b_ + ks_); ATT_TRRD(h1, b_ + ks_ + hf_); ATT_TRRD(l2, b_ + 2 * ks_); ATT_TRRD(h2, b_ + 2 * ks_ + hf_); ATT_TRRD(l3, b_ + 3 * ks_); ATT_TRRD(h3, b_ + 3 * ks_ + hf_); \
        asm volatile("s_waitcnt lgkmcnt(0)" ::: "memory"); ATT_SBAR(); \
        o[d0] = __builtin_amdgcn_mfma_f32_32x32x16_bf16(pa0, (bf16x8){l0[0], l0[1], l0[2], l0[3], h0[0], h0[1], h0[2], h0[3]}, o[d0], 0, 0, 0); \
        o[d0] = __builtin_amdgcn_mfma_f32_32x32x16_bf16(pa1, (bf16x8){l1[0], l1[1], l1[2], l1[3], h1[0], h1[1], h1[2], h1[3]}, o[d0], 0, 0, 0); \
        o[d0] = __builtin_amdgcn_mfma_f32_32x32x16_bf16(pa2, (bf16x8){l2[0], l2[1], l2[2], l2[3], h2[0], h2[1], h2[2], h2[3]}, o[d0], 0, 0, 0); \
        o[d0] = __builtin_amdgcn_mfma_f32_32x32x16_bf16(pa3, (bf16x8){l3[0], l3[1], l3[2], l3[3], h3[0], h3[1], h3[2], h3[3]}, o[d0], 0, 0, 0); } while (0)
__device__ __forceinline__ void pv4(f32x16* o, int vb, bf16x8 pa0, bf16x8 pa1, bf16x8 pa2, bf16x8 pa3) { ATT_PV_D0(4, 0); ATT_PV_D0(4, 1); ATT_PV_D0(4, 2); ATT_PV_D0(4, 3); }
__device__ __forceinline__ void pv2(f32x16* o, int vb, bf16x8 pa0, bf16x8 pa1, bf16x8 pa2, bf16x8 pa3) { ATT_PV_D0(2, 0); ATT_PV_D0(2, 1); }
#define ATT_RESC(ND, a) do { if (__any((a) < 1.f)) { if (hi == 0) al_l[r32] = (a); asm volatile("s_waitcnt lgkmcnt(0)" ::: "memory"); \
        _Pragma("unroll") for (int d_ = 0; d_ < ND; ++d_) _Pragma("unroll") for (int r = 0; r < 16; ++r) o[d_][r] *= al_l[crow(r, hi)]; } } while (0)

__device__ __forceinline__ void mla_unit(int b, int h, int qb, const short* __restrict__ QBp, const short* __restrict__ KBp, const short* __restrict__ VBp, const float* __restrict__ ropec, const float* __restrict__ ropes, short* Op, lptr lds, int wv) {
    int tid_ = TIDX(wv);
    const int tid = tid_, wid = wv, lane = tid & 63, r32 = lane & 31, hi = lane >> 5;
    const size_t rowbase = (size_t)b * SEQ; const int q0 = qb * 256;
    bf16x8 qr[12];
    { const short* qp = QBp + (rowbase + q0 + wid * 32 + r32) * QB_PITCH + h * 192 + hi * 8;
#pragma unroll
      for (int d0 = 0; d0 < 12; ++d0) qr[d0] = *(const bf16x8*)(qp + d0 * 16); }
    f32x4 rc[2][2], rsn[2][2];
    { const size_t ro = (rowbase + q0 + wid * 32 + r32) * 32 + hi * 8;
#pragma unroll
      for (int dd = 0; dd < 2; ++dd) { rc[dd][0] = *(const f32x4*)(ropec + ro + dd * 16); rc[dd][1] = *(const f32x4*)(ropec + ro + dd * 16 + 4); rsn[dd][0] = *(const f32x4*)(ropes + ro + dd * 16); rsn[dd][1] = *(const f32x4*)(ropes + ro + dd * 16 + 4); } }
    const short* Kg = KBp + rowbase * KB_PITCH + h * 192; const short* Vg = VBp + rowbase * VB_PITCH + h * 128;
    const int NT = 4 * (qb + 1);
    const int srow = tid >> 3, sch = tid & 7;
    const int kgo = srow * KB_PITCH + sch * 8, klo = srow * KROW_MLA + sch * 16, vgo = srow * VB_PITCH + sch * 8, vlo = v_st<4>(srow, sch * 8);
    bf16x8 sk[3], sv[2];
#define MLA_LOADT(t) do { const short* kp_ = Kg + (size_t)(t) * 64 * KB_PITCH + kgo; const short* vp_ = Vg + (size_t)(t) * 64 * VB_PITCH + vgo; \
        _Pragma("unroll") for (int i = 0; i < 3; ++i) sk[i] = *(const bf16x8*)(kp_ + 64 * i); _Pragma("unroll") for (int i = 0; i < 2; ++i) sv[i] = *(const bf16x8*)(vp_ + 64 * i); } while (0)
#define MLA_WRITET(bf) do { _Pragma("unroll") for (int i = 0; i < 3; ++i) *(ATT_LAS bf16x8*)(lds + MLA_K + (bf) * KT_MLA + klo + 128 * i) = sk[i]; \
        _Pragma("unroll") for (int i = 0; i < 2; ++i) *(ATT_LAS bf16x8*)(lds + MLA_V + (bf) * VT_MLA + vlo + 1024 * i) = sv[i]; } while (0)
    MLA_LOADT(0);
#pragma unroll
    for (int dd = 0; dd < 2; ++dd) { const f32x4 c0 = rc[dd][0], c1 = rc[dd][1], s0 = rsn[dd][0], s1 = rsn[dd][1];
        const u32x4 w1 = __builtin_bit_cast(u32x4, qr[8 + dd]), w2 = __builtin_bit_cast(u32x4, qr[10 + dd]); u32x4 o1, o2;
#pragma unroll
        for (int e = 0; e < 4; ++e) { const float ca = e < 2 ? c0[2 * e] : c1[2 * e - 4], cb = e < 2 ? c0[2 * e + 1] : c1[2 * e - 3], sa = e < 2 ? s0[2 * e] : s1[2 * e - 4], sb = e < 2 ? s0[2 * e + 1] : s1[2 * e - 3];
            const float x1a = __uint_as_float(w1[e] << 16), x1b = __uint_as_float(w1[e] & 0xffff0000u), x2a = __uint_as_float(w2[e] << 16), x2b = __uint_as_float(w2[e] & 0xffff0000u);
            o1[e] = cvtpk(x1a * ca - x2a * sa, x1b * cb - x2b * sb); o2[e] = cvtpk(x2a * ca + x1a * sa, x2b * cb + x1b * sb); }
        qr[8 + dd] = __builtin_bit_cast(bf16x8, o1); qr[10 + dd] = __builtin_bit_cast(bf16x8, o2); }
    MLA_WRITET(0); __syncthreads();
    float m_reg = -1e30f, l_reg = 0.f; f32x16 o[4] = {};
    ATT_LAS float* al_l = (ATT_LAS float*)(lds + LDS_SCR) + wid * 64; ATT_LAS float* li_l = al_l + 32;
    const int vb0 = (int)(unsigned)(size_t)(lds + MLA_V) + v_rd_base(lane);
    const int qlo = q0 + wid * 32, qpos = qlo + r32;
    f32x16 pA0, pA1, pB0, pB1; float alA, alB; bf16x8 pa0, pa1, pa2, pa3;
#define MLA_SCORE(P0, P1, t_, bf_) qkt<12, KROW_MLA>(P0, P1, lds + MLA_K + (bf_) * KT_MLA, r32, hi, qr)
#define MLA_MASK(P0, P1, t_) do { if ((t_) * 64 + 63 > qlo) { asm volatile("" ::: "memory"); mask_tile(P0, P1, qpos - (t_) * 64 - 4 * hi, 0x7fffffffu); } } while (0)
    MLA_SCORE(pA0, pA1, 0, 0); MLA_MASK(pA0, pA1, 0); partial_sm<8>(pA0, pA1, m_reg, alA);
    MLA_LOADT(1); MLA_WRITET(1); __syncthreads();
    for (int j = 1; j + 1 < NT; j += 2) {
        ATT_SBAR(); MLA_SCORE(pB0, pB1, j, 1);
        finish_sm(pA0, pA1, alA, l_reg, pa0, pa1, pa2, pa3); ATT_SBAR();
        MLA_MASK(pB0, pB1, j); MLA_LOADT(j + 1); ATT_SBAR();
        pv4(o, vb0, pa0, pa1, pa2, pa3); partial_sm<8>(pB0, pB1, m_reg, alB);
        __syncthreads(); MLA_WRITET(0);
        ATT_RESC(4, alB); __syncthreads();
        ATT_SBAR(); MLA_SCORE(pA0, pA1, j + 1, 0);
        finish_sm(pB0, pB1, alB, l_reg, pa0, pa1, pa2, pa3); ATT_SBAR();
        MLA_MASK(pA0, pA1, j + 1); MLA_LOADT(j + 2); ATT_SBAR();
        pv4(o, vb0 + VT_MLA, pa0, pa1, pa2, pa3); partial_sm<8>(pA0, pA1, m_reg, alA);
        __syncthreads(); MLA_WRITET(1);
        ATT_RESC(4, alA); __syncthreads();
    }
    ATT_SBAR(); MLA_SCORE(pB0, pB1, NT - 1, 1);
    finish_sm(pA0, pA1, alA, l_reg, pa0, pa1, pa2, pa3); ATT_SBAR();
    MLA_MASK(pB0, pB1, NT - 1);
    pv4(o, vb0, pa0, pa1, pa2, pa3); partial_sm<8>(pB0, pB1, m_reg, alB);
    ATT_RESC(4, alB);
    finish_sm(pB0, pB1, alB, l_reg, pa0, pa1, pa2, pa3); ATT_SBAR();
    pv4(o, vb0 + VT_MLA, pa0, pa1, pa2, pa3);
    __syncthreads();
#undef MLA_SCORE
#undef MLA_MASK
#undef MLA_LOADT
#undef MLA_WRITET
    if (hi == 0) li_l[r32] = l_reg; asm volatile("s_waitcnt lgkmcnt(0)" ::: "memory");
    float rli[16];
#pragma unroll
    for (int r = 0; r < 16; ++r) rli[r] = __builtin_amdgcn_rcpf(li_l[crow(r, hi)]);
    short* Ow = Op + (rowbase + q0 + wid * 32) * 2048 + 1024 + h * 128;
    { const bool odd = (r32 & 1) != 0;
#pragma unroll
      for (int r = 0; r < 16; r += 2) { const int orow = crow(odd ? r + 1 : r, hi);
#pragma unroll
        for (int d0 = 0; d0 < 4; ++d0) { const float v0 = o[d0][r] * rli[r], v1 = o[d0][r + 1] * rli[r + 1]; const float got = __shfl_xor(odd ? v0 : v1, 1);
            *(unsigned*)(Ow + (size_t)orow * 2048 + d0 * 32 + (r32 & ~1)) = cvtpk(odd ? got : v0, odd ? v1 : got); } } }
}
__device__ __forceinline__ void swa_unit(int b, int kvh, int n, const short* __restrict__ QAp, const short* __restrict__ KAp, const short* __restrict__ VAp, const int* __restrict__ pos, const float* __restrict__ sinks, short* Op, lptr lds, int wv) {
    int tid_ = TIDX(wv);
    const int tid = tid_, wid = wv, lane = tid & 63, r32 = lane & 31, hi = lane >> 5;
    const size_t rowbase = (size_t)b * SEQ; const int key0 = 128 * (n - 1);
    ATT_LAS int* posl = (ATT_LAS int*)(lds + SWA_POS);
    const int rho = wid & 3, hqA = 4 * kvh + (wid >> 2), hqB = hqA + 2, qrow0 = 128 * n + 32 * rho;
    bf16x8 qrA[4], qrB[4];
    { const short* qp = QAp + (rowbase + qrow0 + r32) * QA_PITCH + hi * 8;
#pragma unroll
      for (int d0 = 0; d0 < 4; ++d0) { qrA[d0] = *(const bf16x8*)(qp + hqA * 64 + d0 * 16); qrB[d0] = *(const bf16x8*)(qp + hqB * 64 + d0 * 16); } }
    const int pq = pos[rowbase + qrow0 + r32];
    const float sinkA = sinks[hqA], sinkB = sinks[hqB];
#pragma unroll
    for (int i = 0; i < 4; ++i) { const int c = tid + 512 * i, row = c >> 3, ch = c & 7;
        if (key0 + row >= 0) {
            const bf16x8 kk = *(const bf16x8*)(KAp + (rowbase + key0 + row) * KA_PITCH + kvh * 64 + ch * 8);
            const bf16x8 vv = *(const bf16x8*)(VAp + (rowbase + key0 + row) * VA_PITCH + kvh * 64 + ch * 8);
            *(ATT_LAS bf16x8*)(lds + SWA_K + row * KROW_SWA + ch * 16) = kk;
            *(ATT_LAS bf16x8*)(lds + SWA_V + (row >> 6) * VT_SWA + v_st<2>(row & 63, ch * 8)) = vv; } }
    if (tid < 256 && key0 + tid >= 0) posl[tid] = pos[rowbase + key0 + tid];
    __syncthreads();
    ATT_LAS float* al_l = (ATT_LAS float*)(lds + LDS_SCR) + wid * 64; ATT_LAS float* li_l = al_l + 32;
    const int vb0 = (int)(unsigned)(size_t)(lds + SWA_V) + v_rd_base(lane);
    const float slopeA = __builtin_amdgcn_exp2f(-0.5f * (float)(hqA + 1)) * LOG2E, slopeB = __builtin_amdgcn_exp2f(-0.5f * (float)(hqB + 1)) * LOG2E;
    float one_ = 1.0f; asm volatile("" : "+v"(one_));
    float mA = sinkA * LOG2E, lA = one_, mB = sinkB * LOG2E, lB = one_; f32x16 oA[2] = {}, oB[2] = {};
#define SWA_RESC(O, a) do { if (__any((a) < 1.f)) { if (hi == 0) al_l[r32] = (a); asm volatile("s_waitcnt lgkmcnt(0)" ::: "memory"); \
        _Pragma("unroll") for (int d_ = 0; d_ < 2; ++d_) _Pragma("unroll") for (int r = 0; r < 16; ++r) O[d_][r] *= al_l[crow(r, hi)]; asm volatile("s_waitcnt lgkmcnt(0)" ::: "memory"); } } while (0)
    for (int j = 0; j < 3; ++j) { const int lt = (rho >> 1) + j;
        if (n == 0 && lt < 2) continue;
        f32x16 pA0 = {}, pA1 = {}, pB0 = {}, pB1 = {};
        { const lptr a = lds + SWA_K + lt * KT_SWA + r32 * KROW_SWA + hi * 16;
#pragma unroll
          for (int d0 = 0; d0 < 4; ++d0) { const bf16x8 b0 = *(const ATT_LAS bf16x8*)(a + d0 * 32), b1 = *(const ATT_LAS bf16x8*)(a + 32 * KROW_SWA + d0 * 32);
              pA0 = __builtin_amdgcn_mfma_f32_32x32x16_bf16(b0, qrA[d0], pA0, 0, 0, 0); pB0 = __builtin_amdgcn_mfma_f32_32x32x16_bf16(b0, qrB[d0], pB0, 0, 0, 0);
              pA1 = __builtin_amdgcn_mfma_f32_32x32x16_bf16(b1, qrA[d0], pA1, 0, 0, 0); pB1 = __builtin_amdgcn_mfma_f32_32x32x16_bf16(b1, qrB[d0], pB1, 0, 0, 0); } }
#pragma unroll
        for (int g4 = 0; g4 < 4; ++g4) { const i32x4 k0 = *(const ATT_LAS i32x4*)(posl + lt * 64 + 8 * g4 + 4 * hi), k1 = *(const ATT_LAS i32x4*)(posl + lt * 64 + 32 + 8 * g4 + 4 * hi);
#pragma unroll
            for (int e = 0; e < 4; ++e) { int d0_ = pq - k0[e], d1_ = pq - k1[e]; d0_ = d0_ < 0 ? -d0_ : d0_; d1_ = d1_ < 0 ? -d1_ : d1_; const float f0 = (float)d0_, f1 = (float)d1_;
                pA0[4 * g4 + e] -= slopeA * f0; pA1[4 * g4 + e] -= slopeA * f1; pB0[4 * g4 + e] -= slopeB * f0; pB1[4 * g4 + e] -= slopeB * f1; } }
        { const int dq = (qrow0 + r32) - (key0 + 64 * lt) - 4 * hi; mask_tile(pA0, pA1, dq, 128u); mask_tile(pB0, pB1, dq, 128u); }
        float alA, alB; bf16x8 a0, a1, a2, a3, b0_, b1_, b2_, b3_;
        softmax_tile<8>(pA0, pA1, mA, lA, alA, a0, a1, a2, a3);
        softmax_tile<8>(pB0, pB1, mB, lB, alB, b0_, b1_, b2_, b3_);
        SWA_RESC(oA, alA); SWA_RESC(oB, alB);
        { const int vb = vb0 + lt * VT_SWA;
#define SWA_PV2(d0) do { s16x4 l0, l1, l2, l3, h0, h1, h2, h3; constexpr int b_ = (d0) * 512, ks_ = 2 * 1024, hf_ = 2 * 512; \
          ATT_TRRD(l0, b_); ATT_TRRD(h0, b_ + hf_); ATT_TRRD(l1, b_ + ks_); ATT_TRRD(h1, b_ + ks_ + hf_); ATT_TRRD(l2, b_ + 2 * ks_); ATT_TRRD(h2, b_ + 2 * ks_ + hf_); ATT_TRRD(l3, b_ + 3 * ks_); ATT_TRRD(h3, b_ + 3 * ks_ + hf_); \
          asm volatile("s_waitcnt lgkmcnt(0)" ::: "memory"); ATT_SBAR(); \
          const bf16x8 v0_ = (bf16x8){l0[0], l0[1], l0[2], l0[3], h0[0], h0[1], h0[2], h0[3]}, v1_ = (bf16x8){l1[0], l1[1], l1[2], l1[3], h1[0], h1[1], h1[2], h1[3]}; \
          const bf16x8 v2_ = (bf16x8){l2[0], l2[1], l2[2], l2[3], h2[0], h2[1], h2[2], h2[3]}, v3_ = (bf16x8){l3[0], l3[1], l3[2], l3[3], h3[0], h3[1], h3[2], h3[3]}; \
          oA[d0] = __builtin_amdgcn_mfma_f32_32x32x16_bf16(a0, v0_, oA[d0], 0, 0, 0); oB[d0] = __builtin_amdgcn_mfma_f32_32x32x16_bf16(b0_, v0_, oB[d0], 0, 0, 0); \
          oA[d0] = __builtin_amdgcn_mfma_f32_32x32x16_bf16(a1, v1_, oA[d0], 0, 0, 0); oB[d0] = __builtin_amdgcn_mfma_f32_32x32x16_bf16(b1_, v1_, oB[d0], 0, 0, 0); \
          oA[d0] = __builtin_amdgcn_mfma_f32_32x32x16_bf16(a2, v2_, oA[d0], 0, 0, 0); oB[d0] = __builtin_amdgcn_mfma_f32_32x32x16_bf16(b2_, v2_, oB[d0], 0, 0, 0); \
          oA[d0] = __builtin_amdgcn_mfma_f32_32x32x16_bf16(a3, v3_, oA[d0], 0, 0, 0); oB[d0] = __builtin_amdgcn_mfma_f32_32x32x16_bf16(b3_, v3_, oB[d0], 0, 0, 0); } while (0)
          SWA_PV2(0); SWA_PV2(1);
#undef SWA_PV2
        }
    }
#undef SWA_RESC
#define SWA_EPI(O, L, HQ) do { if (hi == 0) li_l[r32] = (L); asm volatile("s_waitcnt lgkmcnt(0)" ::: "memory"); float rli[16]; \
        _Pragma("unroll") for (int r = 0; r < 16; ++r) rli[r] = __builtin_amdgcn_rcpf(li_l[crow(r, hi)]); asm volatile("s_waitcnt lgkmcnt(0)" ::: "memory"); \
        short* Ow = Op + (rowbase + qrow0) * 2048 + (HQ) * 64; \
        const bool odd = (r32 & 1) != 0; \
        _Pragma("unroll") for (int r = 0; r < 16; r += 2) { const int orow = crow(odd ? r + 1 : r, hi); \
            _Pragma("unroll") for (int d0 = 0; d0 < 2; ++d0) { const float v0 = O[d0][r] * rli[r], v1 = O[d0][r + 1] * rli[r + 1]; const float got = __shfl_xor(odd ? v0 : v1, 1); \
                *(unsigned*)(Ow + (size_t)orow * 2048 + d0 * 32 + (r32 & ~1)) = cvtpk(odd ? got : v0, odd ? v1 : got); } } } while (0)
    SWA_EPI(oA, lA, hqA); SWA_EPI(oB, lB, hqB);
#undef SWA_EPI
    __syncthreads();
}
#undef ATT_RESC
}
constexpr int NWAVES = 8;
#ifndef PROBE_DUP_P0
#define PROBE_DUP_P0 1
#endif
#ifndef PROBE_DUP_ATT
#define PROBE_DUP_ATT 1
#endif
constexpr int CW_BAR = 4096;
constexpr int RING_BYTES = 131072, EPI_T_OFF = RING_BYTES, MISC_OFF = RING_BYTES + 4096, RS_OFF = MISC_OFF + 1024, CS_OFF = RS_OFF + 2048, CS_UNITS = 12, LDS_BYTES = 151552;
static_assert(att::ATT_LDS_BYTES <= RING_BYTES, "attention scratch fits the ring region");
static_assert(CS_OFF + CS_UNITS * 1024 <= LDS_BYTES, "LDS tables fit");

#define GAS __attribute__((address_space(1)))
#define LAS __attribute__((address_space(3)))
typedef unsigned short bf16;
typedef unsigned v4u __attribute__((ext_vector_type(4)));
typedef float f32x4 __attribute__((ext_vector_type(4)));
typedef short bf16x8 __attribute__((ext_vector_type(8)));
typedef GAS unsigned gu32;
typedef GAS unsigned long long gu64;
#define RLX_AGENT __ATOMIC_RELAXED, __HIP_MEMORY_SCOPE_AGENT
#define LDS_WAIT() asm volatile("s_waitcnt lgkmcnt(0)" ::: "memory")
#define VM_WAIT() asm volatile("s_waitcnt vmcnt(0)" ::: "memory")
__device__ __forceinline__ unsigned long long rt() { return __builtin_amdgcn_s_memrealtime(); }
__device__ __forceinline__ unsigned f2bf(float f) { unsigned u = __builtin_bit_cast(unsigned, f); return (u + 0x7fffu + ((u >> 16) & 1u)) >> 16; }
__device__ __forceinline__ unsigned pk2(float lo, float hi) { return f2bf(lo) | (f2bf(hi) << 16); }

#define XB_TMO      128
#define XB_XCNT(j)  (256  + 64 * (j))
#define XB_XSUB(j)  (1280 + 64 * (j))
#define XB_XGEN(j)  (2304 + 64 * (j))
#define XB_TOP      3328
#define XB_TOPGEN   3392
#define XCD_BAR_WORDS 3456
#define XB_SPIN_CAP (1u << 18)

__device__ __forceinline__ unsigned xb_ld(unsigned* p)              { return __hip_atomic_load(p, __ATOMIC_RELAXED, __HIP_MEMORY_SCOPE_AGENT); }
__device__ __forceinline__ unsigned xb_add(unsigned* p, unsigned v) { return __hip_atomic_fetch_add(p, v, __ATOMIC_RELAXED, __HIP_MEMORY_SCOPE_AGENT); }
__device__ __forceinline__ unsigned xb_xcc_id() { return (unsigned)__builtin_amdgcn_s_getreg((3 << 11) | 20) & 0xFu; }
#define XB_SPIN(cond, bar) do { unsigned _sp = 0; while (cond) { __builtin_amdgcn_s_sleep(1); \
    if ((++_sp & 255u) == 0u) { if (xb_ld(&(bar)[XB_TMO])) break; if (_sp > XB_SPIN_CAP) { atomicAdd(&(bar)[XB_TMO], 1u); break; } } } } while (0)

struct XcdBarrier {
    unsigned* bar; unsigned x;
    volatile LAS unsigned* st;
};

__device__ __forceinline__ XcdBarrier xcd_barrier_post(unsigned* bar, volatile LAS unsigned* st, int wv) {
    XcdBarrier b; b.bar = bar; b.x = xb_xcc_id(); b.st = st;
    if (TIDX(wv) == 0) (void)xb_add(&bar[XB_XCNT(b.x)], 1u);
    return b;
}
__device__ __forceinline__ void xcd_barrier_complete(unsigned* bar, unsigned x, unsigned& nloc, unsigned& nx) {
    const unsigned G = gridDim.x * gridDim.y * gridDim.z;
    unsigned sum, cnt, mine, sp = 0u;
    for (;;) {
        sum = 0u; cnt = 0u; mine = 0u;
#pragma unroll
        for (unsigned j = 0; j < 16; ++j) { const unsigned c = xb_ld(&bar[XB_XCNT(j)]); sum += c; cnt += (c > 0u) ? 1u : 0u; mine = (j == x) ? c : mine; }
        if (sum == G) break;
        __builtin_amdgcn_s_sleep(1);
        if ((++sp & 255u) == 0u) { if (xb_ld(&bar[XB_TMO])) break; if (sp > XB_SPIN_CAP) { atomicAdd(&bar[XB_TMO], 1u); break; } }
    }
    nloc = mine > 0u ? mine : 1u; nx = cnt > 0u ? cnt : 1u;
}

__device__ __forceinline__ void xcd_barrier(const XcdBarrier& b, int wv) {
    asm volatile("s_waitcnt vmcnt(0)" ::: "memory");
    __syncthreads();
    if (TIDX(wv) == 0) {
        unsigned* bar = b.bar; unsigned bxcc = b.x; asm volatile("" : "+s"(bar), "+s"(bxcc));
        __builtin_amdgcn_s_waitcnt(0);
        unsigned nloc = b.st[0], nx = b.st[1];
        if (nloc == 0u) { xcd_barrier_complete(bar, bxcc, nloc, nx); b.st[0] = nloc; b.st[1] = nx; }
        const unsigned old = xb_add(&bar[XB_XSUB(bxcc)], 1u);
        const unsigned gen = old / nloc;
        if (old + 1u == (gen + 1u) * nloc) {
            __builtin_amdgcn_fence(__ATOMIC_RELEASE, "agent");
            asm volatile("s_waitcnt vmcnt(0)" ::: "memory");
            const unsigned og = xb_add(&bar[XB_TOP], 1u);
            const unsigned tg = og / nx;
            if (og + 1u == (tg + 1u) * nx) xb_add(&bar[XB_TOPGEN], 1u);
            else XB_SPIN(xb_ld(&bar[XB_TOPGEN]) == tg, bar);
            __builtin_amdgcn_fence(__ATOMIC_ACQUIRE, "agent");
            xb_add(&bar[XB_XGEN(bxcc)], 1u);
            asm volatile("s_waitcnt vmcnt(0)" ::: "memory");
        } else {
            XB_SPIN(xb_ld(&bar[XB_XGEN(bxcc)]) == gen, bar);
            __builtin_amdgcn_fence(__ATOMIC_ACQUIRE, "agent");
            asm volatile("s_waitcnt vmcnt(0)" ::: "memory");
        }
    }
    __syncthreads();
}

constexpr int CW_GXCC = 24576;
constexpr int CW_GRP = 16384;
__device__ __forceinline__ void group_barrier(unsigned* cnt, unsigned target, unsigned* tmo, int wv, bool same_xcd) {
    asm volatile("s_waitcnt vmcnt(0)" ::: "memory");
    __syncthreads();
    if (TIDX(wv) == 0) {
        if (same_xcd) __builtin_amdgcn_fence(__ATOMIC_RELEASE, "workgroup"); else __builtin_amdgcn_fence(__ATOMIC_RELEASE, "agent");
        asm volatile("s_waitcnt vmcnt(0)" ::: "memory");
        (void)xb_add(cnt, 1u);
        unsigned sp = 0u;
        while (xb_ld(cnt) < target) { __builtin_amdgcn_s_sleep(1); if ((++sp & 255u) == 0u) { if (xb_ld(tmo)) break; if (sp > XB_SPIN_CAP) { atomicAdd(tmo, 1u); break; } } }
        __builtin_amdgcn_fence(__ATOMIC_ACQUIRE, "agent");
        asm volatile("s_waitcnt vmcnt(0)" ::: "memory");
    }
    __syncthreads();
}
constexpr float I8_MAGIC = 12582912.0f;
typedef unsigned v2u __attribute__((ext_vector_type(2)));
__device__ __forceinline__ unsigned pack4_i8(float a, float b, float c, float d) {
    return __builtin_amdgcn_perm(__builtin_bit_cast(unsigned, b), __builtin_bit_cast(unsigned, a), 0x0c0c0400u) | __builtin_amdgcn_perm(__builtin_bit_cast(unsigned, d), __builtin_bit_cast(unsigned, c), 0x04000c0cu);
}
__device__ __forceinline__ void quant_panel(const bf16* __restrict__ X, signed char* __restrict__ Q8, float* __restrict__ rsg, LAS float* rst, int r0, int rbase, int ntrips, int lane) {
    for (int t = 0; t < ntrips; ++t) {
        const int rb = rbase + t * 4;
        v4u x[4][4];
#pragma unroll
        for (int i = 0; i < 4; ++i)
#pragma unroll
            for (int j = 0; j < 4; ++j) x[i][j] = *(const v4u*)(X + (size_t)(rb + i) * DM + j * 512 + lane * 8);
#pragma unroll
        for (int i = 0; i < 4; ++i) { float am = 0.f, ss = 0.f;
#pragma unroll
            for (int j = 0; j < 4; ++j)
#pragma unroll
                for (int e = 0; e < 4; ++e) { const float lo = pg8::bf_lo(x[i][j][e]), hi = pg8::bf_hi(x[i][j][e]); am = fmaxf(am, fmaxf(fabsf(lo), fabsf(hi))); ss += lo * lo + hi * hi; }
#pragma unroll
            for (int o = 1; o < 64; o <<= 1) { am = fmaxf(am, __shfl_xor(am, o)); ss += __shfl_xor(ss, o); }
            am = fmaxf(am, 1e-30f); const float inv = 127.0f * __builtin_amdgcn_rcpf(am);
#pragma unroll
            for (int j = 0; j < 4; ++j) { float q[8];
#pragma unroll
                for (int e = 0; e < 4; ++e) { q[2 * e] = __builtin_fmaf(pg8::bf_lo(x[i][j][e]), inv, I8_MAGIC); q[2 * e + 1] = __builtin_fmaf(pg8::bf_hi(x[i][j][e]), inv, I8_MAGIC); }
                v2u o; o.x = pack4_i8(q[0], q[1], q[2], q[3]); o.y = pack4_i8(q[4], q[5], q[6], q[7]);
                *(v2u*)(Q8 + (size_t)(rb + i) * DM + j * 512 + lane * 8) = o; }
            if (lane == 0) { const float sc = pg8::rsq(ss * (1.0f / DM) + EPS) * am * (1.0f / 127.0f); rsg[rb + i] = sc; if (rst) rst[rb + i - r0] = sc; } }
    }
}
__device__ __forceinline__ void cvt_strip8(const float* __restrict__ W, int ldw, int c0, const float* __restrict__ gain, signed char* __restrict__ dst, int n0, float* __restrict__ wsc, LAS float* scr, LAS float* cmx, int wave, int lane) {
    const int c = lane & 7;
    f32x4 v[4][8]; f32x4 mx = (f32x4){0.f, 0.f, 0.f, 0.f};
#pragma unroll
    for (int it = 0; it < 4; ++it)
#pragma unroll
        for (int i = 0; i < 8; ++i) { const int kk = (wave * 4 + it) * 64 + 8 * i + (lane >> 3);
            v[it][i] = *(const f32x4*)(W + (size_t)kk * ldw + c0 + 4 * c) * gain[kk];
#pragma unroll
            for (int e = 0; e < 4; ++e) mx[e] = fmaxf(mx[e], fabsf(v[it][i][e])); }
#pragma unroll
    for (int o = 8; o < 64; o <<= 1)
#pragma unroll
        for (int e = 0; e < 4; ++e) mx[e] = fmaxf(mx[e], __shfl_xor(mx[e], o));
    if (lane < 8) *(LAS f32x4*)(cmx + wave * 32 + 4 * c) = mx;
    __syncthreads();
    f32x4 cm = *(const LAS f32x4*)(cmx + 4 * c);
#pragma unroll
    for (int w = 1; w < 8; ++w) { const f32x4 t = *(const LAS f32x4*)(cmx + w * 32 + 4 * c);
#pragma unroll
        for (int e = 0; e < 4; ++e) cm[e] = fmaxf(cm[e], t[e]); }
    f32x4 inv;
#pragma unroll
    for (int e = 0; e < 4; ++e) { cm[e] = fmaxf(cm[e], 1e-30f); inv[e] = 127.0f * __builtin_amdgcn_rcpf(cm[e]); }
    if (wave == 0 && lane < 8) *(f32x4*)(wsc + n0 + 4 * c) = cm * (1.0f / 127.0f);
#pragma unroll
    for (int it = 0; it < 4; ++it) { const int k0 = (wave * 4 + it) * 64;
#pragma unroll
        for (int i = 0; i < 8; ++i) { const int kk = 8 * i + (lane >> 3); LAS float* s = scr + kk * 33 + 4 * c;
#pragma unroll
            for (int e = 0; e < 4; ++e) s[e] = __builtin_fmaf(v[it][i][e], inv[e], I8_MAGIC); }
        LDS_WAIT(); asm volatile("" ::: "memory");
#pragma unroll
        for (int j = 0; j < 4; ++j) { const int n = (lane >> 3) + 8 * j; const LAS float* s = scr + (8 * c) * 33 + n;
            v2u o; o.x = pack4_i8(s[0 * 33], s[1 * 33], s[2 * 33], s[3 * 33]); o.y = pack4_i8(s[4 * 33], s[5 * 33], s[6 * 33], s[7 * 33]);
            *(v2u*)(dst + (size_t)(n0 + n) * DM + k0 + 8 * c) = o; }
        LDS_WAIT(); asm volatile("" ::: "memory"); }
    __syncthreads();
}
__device__ __forceinline__ void cvt_strip8_2p(const float* __restrict__ W, int ldw, int c0, int nkb, signed char* __restrict__ dst, int Kd, int n0, float* __restrict__ wsc, LAS float* scr, LAS float* cmx, int wave, int lane) {
    const int c = lane & 7;
    f32x4 mx = (f32x4){0.f, 0.f, 0.f, 0.f};
    for (int kb = wave; kb < nkb; kb += 8) {
#pragma unroll
        for (int i = 0; i < 8; ++i) { const int kk = kb * 64 + 8 * i + (lane >> 3); const f32x4 v = *(const f32x4*)(W + (size_t)kk * ldw + c0 + 4 * c);
#pragma unroll
            for (int e = 0; e < 4; ++e) mx[e] = fmaxf(mx[e], fabsf(v[e])); } }
#pragma unroll
    for (int o = 8; o < 64; o <<= 1)
#pragma unroll
        for (int e = 0; e < 4; ++e) mx[e] = fmaxf(mx[e], __shfl_xor(mx[e], o));
    if (lane < 8) *(LAS f32x4*)(cmx + wave * 32 + 4 * c) = mx;
    __syncthreads();
    f32x4 cm = *(const LAS f32x4*)(cmx + 4 * c);
#pragma unroll
    for (int w = 1; w < 8; ++w) { const f32x4 t = *(const LAS f32x4*)(cmx + w * 32 + 4 * c);
#pragma unroll
        for (int e = 0; e < 4; ++e) cm[e] = fmaxf(cm[e], t[e]); }
    f32x4 inv;
#pragma unroll
    for (int e = 0; e < 4; ++e) { cm[e] = fmaxf(cm[e], 1e-30f); inv[e] = 127.0f * __builtin_amdgcn_rcpf(cm[e]); }
    if (wave == 0 && lane < 8) *(f32x4*)(wsc + n0 + 4 * c) = cm * (1.0f / 127.0f);
    for (int kb = wave; kb < nkb; kb += 8) { const int k0 = kb * 64;
#pragma unroll
        for (int i = 0; i < 8; ++i) { const int kk = 8 * i + (lane >> 3); const f32x4 v = *(const f32x4*)(W + (size_t)(k0 + kk) * ldw + c0 + 4 * c); LAS float* s = scr + kk * 33 + 4 * c;
#pragma unroll
            for (int e = 0; e < 4; ++e) s[e] = __builtin_fmaf(v[e], inv[e], I8_MAGIC); }
        LDS_WAIT(); asm volatile("" ::: "memory");
#pragma unroll
        for (int j = 0; j < 4; ++j) { const int n = (lane >> 3) + 8 * j; const LAS float* s = scr + (8 * c) * 33 + n;
            v2u o; o.x = pack4_i8(s[0 * 33], s[1 * 33], s[2 * 33], s[3 * 33]); o.y = pack4_i8(s[4 * 33], s[5 * 33], s[6 * 33], s[7 * 33]);
            *(v2u*)(dst + (size_t)(n0 + n) * Kd + k0 + 8 * c) = o; }
        LDS_WAIT(); asm volatile("" ::: "memory"); }
    __syncthreads();
}
__device__ __forceinline__ void quant_rows_u(const bf16* __restrict__ U, signed char* __restrict__ Q, float* __restrict__ rsu, int m0, int m1, int ms, int lane) {
    for (int m = m0; m < m1; m += ms) {
        v4u x[2][11];
#pragma unroll
        for (int i = 0; i < 2; ++i)
#pragma unroll
            for (int j = 0; j < 11; ++j) x[i][j] = *(const v4u*)(U + (size_t)(m + i) * DFF + j * 512 + lane * 8);
#pragma unroll
        for (int i = 0; i < 2; ++i) { float am = 0.f;
#pragma unroll
            for (int j = 0; j < 11; ++j)
#pragma unroll
                for (int e = 0; e < 4; ++e) am = fmaxf(am, fmaxf(fabsf(pg8::bf_lo(x[i][j][e])), fabsf(pg8::bf_hi(x[i][j][e]))));
#pragma unroll
            for (int o = 1; o < 64; o <<= 1) am = fmaxf(am, __shfl_xor(am, o));
            am = fmaxf(am, 1e-30f); const float inv = 127.0f * __builtin_amdgcn_rcpf(am);
#pragma unroll
            for (int j = 0; j < 11; ++j) { float q[8];
#pragma unroll
                for (int e = 0; e < 4; ++e) { q[2 * e] = __builtin_fmaf(pg8::bf_lo(x[i][j][e]), inv, I8_MAGIC); q[2 * e + 1] = __builtin_fmaf(pg8::bf_hi(x[i][j][e]), inv, I8_MAGIC); }
                v2u o; o.x = pack4_i8(q[0], q[1], q[2], q[3]); o.y = pack4_i8(q[4], q[5], q[6], q[7]);
                *(v2u*)(Q + (size_t)(m + i) * DFF + j * 512 + lane * 8) = o; }
            if (lane == 0) rsu[m + i] = am * (1.0f / 127.0f); }
    }
}
__device__ __forceinline__ void cvt_item(const float* __restrict__ W, int ldw, int c0, int k0, const float* __restrict__ gain, bf16* dst, int K, int n0, LAS float* scr, int lane) {
    const int c = lane & 7;
    if (c0 < 0) {
#pragma unroll
        for (int j = 0; j < 4; ++j) { const int n = (lane >> 3) + 8 * j; *(v4u*)(dst + (size_t)(n0 + n) * K + k0 + 8 * c) = (v4u){0u, 0u, 0u, 0u}; }
        return;
    }
#pragma unroll
    for (int i = 0; i < 8; ++i) { const int kk = 8 * i + (lane >> 3);
        f32x4 v = *(const f32x4*)(W + (size_t)(k0 + kk) * ldw + c0 + 4 * c);
        if (gain) v = v * gain[k0 + kk];
        LAS float* s = scr + kk * 33 + 4 * c; s[0] = v[0]; s[1] = v[1]; s[2] = v[2]; s[3] = v[3]; }
    LDS_WAIT(); asm volatile("" ::: "memory");
#pragma unroll
    for (int j = 0; j < 4; ++j) { const int n = (lane >> 3) + 8 * j; const LAS float* s = scr + (8 * c) * 33 + n;
        v4u o; o.x = pk2(s[0 * 33], s[1 * 33]); o.y = pk2(s[2 * 33], s[3 * 33]); o.z = pk2(s[4 * 33], s[5 * 33]); o.w = pk2(s[6 * 33], s[7 * 33]);
        *(v4u*)(dst + (size_t)(n0 + n) * K + k0 + 8 * c) = o; }
    LDS_WAIT(); asm volatile("" ::: "memory");
}
__device__ __forceinline__ float wave_sum(float v) {
#pragma unroll
    for (int o = 1; o < 64; o <<= 1) v += __shfl_xor(v, o);
    return v;
}

__device__ __forceinline__ int opaque_i(int v) { asm volatile("" : "+s"(v)); return v; }
struct Args { const void* in[29]; float* out; unsigned char* ws; };

__device__ __forceinline__ int win_src_col(int g32) {
    const int tile = g32 >> 3, bj = (g32 >> 2) & 1, wc = g32 & 3;
    if (tile < 4) return (4 * tile + wc) * 64 + 32 * bj;
    if (tile == 4) return 1024 + wc * 64 + 32 * bj;
    if (tile < 9) return 1280 + (tile - 5) * 256 + (g32 & 7) * 32;
    return wc == 0 ? 2304 + 32 * bj : -1;
}

__device__ __forceinline__ bool quant_prepass(const pg8::StaticOrder& S, const bf16* X, unsigned char* ws, LAS float* rst, volatile LAS int* pnl, int& nu, bool use_group, bool grp_local, int bxi, unsigned& gseq, int wv) {
    const int tidq = TIDX(wv), laneq = tidq & 63, waveq = wv;
    signed char* Q8 = (signed char*)(ws + WS_QA8); float* rsg = (float*)(ws + WS_RSQ8);
    bool onepanel = true; int n = 0, p0 = -1;
    { pg8::Unit ui_; for (int i_ = 0; S.next(i_, ui_); ++i_) { if (i_ == 0) p0 = ui_.pm; onepanel = onepanel && (ui_.pm == p0); ++n; if (pnl && tidq == 0 && i_ < CS_UNITS) pnl[i_] = ui_.pn; } }
    nu = n;
    const bool split = use_group;
    if (split) {
        quant_panel(X, Q8, rsg, (LAS float*)nullptr, p0 * 256, p0 * 256 + (bxi >> 6) * 64 + waveq * 8, 2, laneq);
        unsigned* ctl = (unsigned*)(ws + WS_CTL); gseq += 4u; group_barrier(ctl + CW_GRP + 64 * p0, gseq, ctl + CW_BAR + XB_TMO, wv, grp_local);
        if (tidq < 256) rst[tidq] = rsg[p0 * 256 + tidq];
    } else { pg8::Unit ui_; int prev = -1;
        for (int i_ = 0; S.next(i_, ui_); ++i_) if (ui_.pm != prev) { quant_panel(X, Q8, rsg, i_ == 0 ? rst : (LAS float*)nullptr, ui_.pm * 256, ui_.pm * 256 + waveq * 32, 8, laneq); prev = ui_.pm; } }
    return onepanel;
}
#define ONE_PANEL(S_, u0_, flag_) do { pg8::Unit ui_; flag_ = S_.next(0, u0_); for (int i_ = 1; S_.next(i_, ui_); ++i_) flag_ = flag_ && (ui_.pm == u0_.pm); } while (0)
#define FILL_RS(tab_, slot_, pm_) do { const int tq_ = TIDX(wave); if (tq_ < 256) { const float* p_ = (slot_) + (size_t)((pm_) * 256 + tq_) * 32; float t_ = 0.f; \
        _Pragma("unroll") for (int j_ = 0; j_ < 8; ++j_) { const f32x4 v_ = *(const f32x4*)(p_ + 4 * j_); t_ += (v_[0] + v_[1]) + (v_[2] + v_[3]); } \
        (tab_)[tq_] = pg8::rsq(t_ * (1.0f / DM) + EPS); } } while (0)
__global__ void __launch_bounds__(NWAVES * 64, 2) hybrid_fwd(Args args) {
    extern __shared__ __attribute__((aligned(16))) unsigned char lds_raw[];
    LAS unsigned char* lds = (LAS unsigned char*)lds_raw;
    volatile LAS unsigned* MISC = (volatile LAS unsigned*)(lds + MISC_OFF);
    const int tid = threadIdx.x, lane = tid & 63, wave = __builtin_amdgcn_readfirstlane(tid >> 6);
    const int G = gridDim.x, bx = blockIdx.x, vcu = (G % 8 == 0) ? (bx % 8) * (G / 8) + bx / 8 : bx;
    const KArg ka0 = (KArg)__builtin_amdgcn_kernarg_segment_ptr();
    for (int u = tid; u < (LDS_BYTES - MISC_OFF) / 4; u += NWAVES * 64) ((LAS unsigned*)(lds + MISC_OFF))[u] = 0u;
    __syncthreads();
    XcdBarrier bar = xcd_barrier_post((unsigned*)(ka_ptr<unsigned char>(ka0, KA_WS) + WS_CTL) + CW_BAR, MISC + 8, wave);
#define GRID_BAR() xcd_barrier(bar, wave)
    unsigned gseq = 0u;
    bool use_group;
    { bool okc = (G == 256);
      if (okc && tid < 256) { const int c = tid, pg = 8 * (c % 8) + (c / 8) % 8;
          for (int w = 0; w < 3; ++w) { pg8::StaticOrder T; T.init(MROWS, w == 0 ? 11264 : w == 1 ? DM : NIN, G, c); pg8::Unit ui_; int n_ = 0; for (int i_ = 0; T.next(i_, ui_); ++i_) { okc = okc && (ui_.pm == pg); ++n_; } okc = okc && (n_ > 0) && (n_ <= CS_UNITS); } }
      if (!okc) MISC[12] = 1u;
      __syncthreads();
      use_group = (MISC[12] == 0u); }
    if (use_group && tid == 0) __hip_atomic_store((unsigned*)(ka_ptr<unsigned char>(ka0, KA_WS) + WS_CTL) + CW_GXCC + 4 * (8 * (bx % 8) + (bx / 8) % 8) + (bx >> 6), bar.x + 1u, __ATOMIC_RELAXED, __HIP_MEMORY_SCOPE_AGENT);
    bool grp_local = false;
#define GROUP_BAR() do { if (use_group) { unsigned* ctl_ = (unsigned*)(ka_ptr<unsigned char>(ka_fresh(ka0), KA_WS) + WS_CTL); gseq += 4u; group_barrier(ctl_ + CW_GRP + 64 * (8 * (bxi % 8) + (bxi / 8) % 8), gseq, ctl_ + CW_BAR + XB_TMO, wave, grp_local); } else xcd_barrier(bar, wave); } while (0)
#define KIN(k, i) ((const float*)ka_ptr<const void>(k, i))
    const int gw = vcu * NWAVES + wave, NGW = G * NWAVES;

#ifndef DBG_NO_P0
    for (int rep_ = 0; rep_ < PROBE_DUP_P0; ++rep_) {
        const KArg k = ka_fresh(ka0); unsigned char* ws = ka_ptr<unsigned char>(k, KA_WS);
        LAS float* scr = (LAS float*)(lds + wave * 16384);
        constexpr int I_GU = (11264 / 32) * (2048 / 64), I_D = (2048 / 32) * (5632 / 64), I_IN = (NIN / 32) * (2048 / 64), I_UQ = (2048 / 32) * (512 / 64), I_UKV = (2048 / 32) * (256 / 64),
                      I_O = (2048 / 32) * (2048 / 64), I_PG = I_O, I_PP = (2048 / 32) * (256 / 64);
        constexpr int I_LAYER = I_IN + I_UQ + I_UKV + I_O + I_PP;
        { const float* xin = KIN(k, 0); bf16* HB = (bf16*)(ws + WS_HB2);
          for (int m = gw; m < MROWS; m += NGW) {
#pragma unroll
              for (int j = 0; j < 4; ++j) { const int col = j * 512 + lane * 8; const f32x4 a = *(const f32x4*)(xin + (size_t)m * DM + col), b2 = *(const f32x4*)(xin + (size_t)m * DM + col + 4);
                  v4u o; o.x = pk2(a[0], a[1]); o.y = pk2(a[2], a[3]); o.z = pk2(b2[0], b2[1]); o.w = pk2(b2[2], b2[3]); *(v4u*)(HB + (size_t)m * DM + col) = o; } } }
        { const float* pin = KIN(k, 1); bf16* PB = (bf16*)(ws + WS_PB); const size_t n8 = (size_t)DEPTH * MROWS * PLE / 8;
          for (size_t i = (size_t)bx * 512 + tid; i < n8; i += (size_t)G * 512) { const f32x4 a = *(const f32x4*)(pin + i * 8), b2 = *(const f32x4*)(pin + i * 8 + 4);
              v4u o; o.x = pk2(a[0], a[1]); o.y = pk2(a[2], a[3]); o.z = pk2(b2[0], b2[1]); o.w = pk2(b2[2], b2[3]); *(v4u*)(PB + i * 8) = o; } }
        { const int* positions = ka_ptr<const int>(k, 2); float* ROPEC = (float*)(ws + WS_ROPEC); float* ROPES = (float*)(ws + WS_ROPES);
          for (int i = bx * 512 + tid; i < MROWS * 32; i += G * 512) { const int m = i >> 5, kk = i & 31;
            const float inv = powf(10000.0f, -(float)kk / 32.0f), ang = (float)positions[m] * inv;
            ROPEC[i] = cosf(ang); ROPES[i] = sinf(ang); } }
        for (int it = gw; it < DEPTH * I_LAYER; it += NGW) {
            const int l = (DEPTH - 1) - it / I_LAYER; int r = (I_LAYER - 1) - it % I_LAYER;
            unsigned char* wl = ws + WS_W + (size_t)l * W_LAYER;
            if (r < I_IN) { const int g32 = r / 32, kb = r % 32;
                cvt_item(KIN(k, 8) + (size_t)l * DM * 2368, 2368, win_src_col(g32), kb * 64, KIN(k, 7) + l * DM, (bf16*)(wl + W_IN), DM, g32 * 32, scr, lane); continue; }
            r -= I_IN;
            if (r < I_UQ) { const int g32 = r / 8, kb = r % 8, h = g32 >> 3, bj = (g32 >> 2) & 1, wc = g32 & 3;
                cvt_item(KIN(k, 13) + (size_t)l * 512 * 1536, 1536, wc < 3 ? h * 192 + 64 * wc + 32 * bj : -1, kb * 64, KIN(k, 12) + l * 512, (bf16*)(wl + W_UQ), 512, g32 * 32, scr, lane); continue; }
            r -= I_UQ;
            if (r < I_UKV) { const int g32 = r / 4, kb = r % 4;
                cvt_item(KIN(k, 15) + (size_t)l * 256 * 2048, 2048, g32 * 32, kb * 64, KIN(k, 14) + l * 256, (bf16*)(wl + W_UKV), 256, g32 * 32, scr, lane); continue; }
            r -= I_UKV;
            if (r < I_O) { const int g32 = r / 32, kb = r % 32;
                const float* gain = kb < 16 ? KIN(k, 18) + l * 1024 : KIN(k, 19) + l * 1024 - 1024;
                cvt_item(KIN(k, 20) + (size_t)l * DM * DM, DM, g32 * 32, kb * 64, gain, (bf16*)(wl + W_O), DM, g32 * 32, scr, lane); continue; }
            r -= I_O;
            { const int g32 = r / 4, kb = r % 4;
                cvt_item(KIN(k, 25) + (size_t)l * PLE * DM, DM, g32 * 32, kb * 64, nullptr, (bf16*)(wl + W_PP), PLE, g32 * 32, scr, lane); }
        }
        { LAS float* cmx = (LAS float*)(lds + EPI_T_OFF);
          for (int s = bx; s < DEPTH * 64; s += G) { const int l = s / 64, g32 = s % 64; int ln_ = lane; asm volatile("" : "+v"(ln_));
              cvt_strip8(KIN(k, 28) + (size_t)l * DM * DM, DM, g32 * 32, KIN(k, 27) + l * DM, (signed char*)(ws + WS_W + (size_t)l * W_LAYER + W_PG), g32 * 32, (float*)(ws + WS_WSCP) + (size_t)l * DM, scr, cmx, wave, ln_); } }
        { LAS float* cmx = (LAS float*)(lds + EPI_T_OFF); constexpr int NSTRIPD = DEPTH * 2 * 64;
          for (int s = bx; s < NSTRIPD; s += G) { const int l = (DEPTH - 1) - s / 128, r = s % 128, f = 1 - r / 64, g32 = r % 64;
              int ln_ = lane; asm volatile("" : "+v"(ln_));
              cvt_strip8_2p(KIN(k, f ? 24 : 6) + (size_t)l * DFF * DM, DM, g32 * 32, DFF / 64, (signed char*)(ws + WS_W + (size_t)l * W_LAYER + (f ? W_2D : W_1D)), DFF, g32 * 32, (float*)(ws + WS_WSCD) + (size_t)(l * 2 + f) * DM, scr, cmx, wave, ln_); } }
        { LAS float* cmx = (LAS float*)(lds + EPI_T_OFF); constexpr int NSTRIP = DEPTH * 2 * 352;
          for (int s = bx; s < NSTRIP; s += G) { const int l = (DEPTH - 1) - s / 704, r = s % 704, f = 1 - r / 352, g32 = r % 352, tile = g32 >> 3, bj = (g32 >> 2) & 1, q = g32 & 3;
              const float* src = KIN(k, f ? (bj ? 23 : 22) : (bj ? 5 : 4)) + (size_t)l * DM * DFF; const float* gain = KIN(k, f ? 21 : 3) + l * DM;
              int ln_ = lane; asm volatile("" : "+v"(ln_));
              cvt_strip8(src, DFF, tile * 128 + q * 32, gain, (signed char*)(ws + WS_W + (size_t)l * W_LAYER + (f ? W_2GU : W_1GU)), g32 * 32, (float*)(ws + WS_WSC) + (size_t)(l * 2 + f) * 11264, scr, cmx, wave, ln_); } }
    }
#endif
    GRID_BAR();
    if (use_group) { if (tid == 0) { unsigned* gx = (unsigned*)(ka_ptr<unsigned char>(ka0, KA_WS) + WS_CTL) + CW_GXCC + 4 * (8 * (bx % 8) + (bx / 8) % 8);
                                     const unsigned x0 = xb_ld(gx), x1 = xb_ld(gx + 1), x2 = xb_ld(gx + 2), x3 = xb_ld(gx + 3); MISC[13] = (x0 != 0u && x0 == x1 && x0 == x2 && x0 == x3) ? 1u : 0u; }
                     __syncthreads(); grp_local = (MISC[13] != 0u); }

    LAS float* epiT = (LAS float*)(lds + EPI_T_OFF);
    for (int hl = 0; hl < 2 * DEPTH; ++hl) {
        int Gi = G, bxi = bx; asm volatile("" : "+s"(Gi), "+s"(bxi));
        const int l = hl >> 1, second = hl & 1;
        { const KArg k = ka_fresh(ka0); unsigned char* ws = ka_ptr<unsigned char>(k, KA_WS);
          pg8::Gemm g{(const bf16*)(ws + WS_QA8), (const bf16*)(ws + WS_W + (size_t)l * W_LAYER + (second ? W_2GU : W_1GU)), MROWS, 11264, DM / 2}; pg8::StaticOrder S; S.init(MROWS, 11264, Gi, bxi);
          LAS float* rst = (LAS float*)(lds + RS_OFF); LAS float* cst = (LAS float*)(lds + CS_OFF); volatile LAS int* pnl = (volatile LAS int*)(lds + EPI_T_OFF);
          int nu = 0; const int tidq = TIDX(wave);
          const bool onepanel = quant_prepass(S, (const bf16*)(ws + (second ? WS_HB : WS_HB2)), ws, rst, pnl, nu, use_group, grp_local, bxi, gseq, wave);
          const bool usetab = onepanel && nu <= CS_UNITS;
          const size_t wsc_off = WS_WSC + (size_t)(l * 2 + second) * 11264 * 4;
          __syncthreads();
          if (usetab) { const float* wsc = (const float*)(ws + wsc_off); float cv[CS_UNITS / 2]; const int tid = tidq;
#pragma unroll
              for (int j = 0; j < CS_UNITS / 2; ++j) { const int idx = j * 512 + tid; cv[j] = (idx >> 8) < nu ? wsc[pnl[idx >> 8] * 256 + (idx & 255)] : 0.f; }
#pragma unroll
              for (int j = 0; j < CS_UNITS / 2; ++j) cst[j * 512 + tid] = cv[j]; }
          VM_WAIT(); __syncthreads();
          pg8::EpiSwiGLU8 E{ka0, onepanel ? (const LAS float*)rst : (const LAS float*)nullptr, usetab ? (const LAS float*)cst : (const LAS float*)nullptr, wsc_off, (bf16*)(ws + WS_U)};
#if !defined(DBG_ONLY) || DBG_ONLY == 0
          pg8::gemm_phase<pg8::EpiSwiGLU8, pg8::StaticOrder, true, true, true>(lds, g, S, E, wave);
#endif
        }
        GROUP_BAR();
        { const KArg k = ka_fresh(ka0); unsigned char* ws = ka_ptr<unsigned char>(k, KA_WS); const int tq_ = TIDX(wave), wq_ = wave;
          if (use_group) { const int m0 = (8 * (bxi % 8) + (bxi / 8) % 8) * 256 + (bxi >> 6) * 64 + wq_ * 8; quant_rows_u((const bf16*)(ws + WS_U), (signed char*)(ws + WS_QU8), (float*)(ws + WS_RSU), m0, m0 + 8, 2, tq_ & 63); }
          else { const int vcu_ = (Gi % 8 == 0) ? (bxi % 8) * (Gi / 8) + bxi / 8 : bxi; quant_rows_u((const bf16*)(ws + WS_U), (signed char*)(ws + WS_QU8), (float*)(ws + WS_RSU), 2 * (vcu_ * NWAVES + wq_), MROWS, 2 * Gi * NWAVES, tq_ & 63); } }
        GROUP_BAR();
        { const KArg k = ka_fresh(ka0); unsigned char* ws = ka_ptr<unsigned char>(k, KA_WS);
          pg8::Gemm g{(const bf16*)(ws + WS_QU8), (const bf16*)(ws + WS_W + (size_t)l * W_LAYER + (second ? W_2D : W_1D)), MROWS, DM, DFF / 2}; pg8::StaticOrder S; S.init(MROWS, DM, Gi, bxi);
          pg8::EpiResid8 E{ka0, second ? -1 : (int)SS_1, 0.5f, second ? WS_HB : WS_HB2, WS_HB, WS_WSCD + (size_t)(l * 2 + second) * DM * 4};
#if !defined(DBG_ONLY) || DBG_ONLY == 1
          pg8::gemm_phase<pg8::EpiResid8, pg8::StaticOrder, true, true, true>(lds, g, S, E, wave);
#endif
        }
        GROUP_BAR();
        if (!second) {
            { const KArg k = ka_fresh(ka0); unsigned char* ws = ka_ptr<unsigned char>(k, KA_WS);
              pg8::Gemm g{(const bf16*)(ws + WS_HB), (const bf16*)(ws + WS_W + (size_t)l * W_LAYER + W_IN), MROWS, NIN, DM}; pg8::StaticOrder S; S.init(MROWS, NIN, Gi, bxi);
              LAS float* rst = (LAS float*)(lds + RS_OFF); bool onepanel; pg8::Unit u0; ONE_PANEL(S, u0, onepanel);
              if (onepanel) { FILL_RS(rst, ka_stats(k, SS_1), u0.pm); __syncthreads(); }
              pg8::EpiWin E{ka0, l, onepanel ? (const LAS float*)rst : (const LAS float*)nullptr};
#if !defined(DBG_ONLY) || DBG_ONLY == 2
              pg8::gemm_phase<pg8::EpiWin, pg8::StaticOrder, true, true>(lds, g, S, E, wave);
#endif
            }
            { const KArg k = ka_fresh(ka0); unsigned char* ws = ka_ptr<unsigned char>(k, KA_WS);
              pg8::Gemm g{(const bf16*)(ws + WS_PB) + (size_t)l * MROWS * PLE, (const bf16*)(ws + WS_W + (size_t)l * W_LAYER + W_PP), MROWS, 2048, opaque_i(PLE)}; pg8::StaticOrder S;
              { const int rem = ((MROWS / 256) * (NIN / 256)) % Gi, nl = Gi - rem;
                if (rem != 0 && rem % 8 == 0 && nl % 8 == 0) S.init(MROWS, 2048, nl, bxi >= rem ? bxi - rem : (1 << 20)); else S.init(MROWS, 2048, Gi, bxi); }
              pg8::EpiStoreSsq E{ka0, (l & 1) ? (int)SS_PP2 : (int)SS_PP, (l & 1) ? WS_PP2 : WS_PP};
#if !defined(DBG_ONLY) || DBG_ONLY == 5
              pg8::gemm_phase<pg8::EpiStoreSsq, pg8::StaticOrder, true, true>(lds, g, S, E, wave);
#endif
            }
            GROUP_BAR();
            { const KArg k = ka_fresh(ka0); unsigned char* ws = ka_ptr<unsigned char>(k, KA_WS);
              pg8::Gemm g{(const bf16*)(ws + WS_CQ), (const bf16*)(ws + WS_W + (size_t)l * W_LAYER + W_UQ), MROWS, 2048, opaque_i(512)}; pg8::StaticOrder S; S.init(MROWS, 2048, Gi, bxi);
              pg8::EpiQB E{ka0, l, epiT};
#if !defined(DBG_ONLY) || DBG_ONLY == 3
              pg8::gemm_phase<pg8::EpiQB, pg8::StaticOrder, true, true>(lds, g, S, E, wave);
#endif
            }
            { const KArg k = ka_fresh(ka0); unsigned char* ws = ka_ptr<unsigned char>(k, KA_WS);
              pg8::Gemm g{(const bf16*)(ws + WS_CKV), (const bf16*)(ws + WS_W + (size_t)l * W_LAYER + W_UKV), MROWS, 2048, opaque_i(256)}; pg8::StaticOrder S; S.init(MROWS, 2048, Gi, bxi);
              pg8::EpiKV E{ka0, l, epiT};
#if !defined(DBG_ONLY) || DBG_ONLY == 4
              pg8::gemm_phase<pg8::EpiKV, pg8::StaticOrder, true, true>(lds, g, S, E, wave);
#endif
            }
            GRID_BAR();
            for (int rep_ = 0; rep_ < PROBE_DUP_ATT; ++rep_) { const KArg k = ka_fresh(ka0); unsigned char* ws = ka_ptr<unsigned char>(k, KA_WS);
#ifndef DBG_NO_MLA
              for (int pi = vcu; pi < 256; pi += G) { const int bh = pi >> 4, s = pi & 15;
                att::mla_unit(bh >> 3, bh & 7, 31 - s, (const short*)(ws + WS_QB), (const short*)(ws + WS_KB), (const short*)(ws + WS_VB), (const float*)(ws + WS_ROPEC), (const float*)(ws + WS_ROPES), (short*)(ws + WS_O), (att::lptr)lds, wave);
                att::mla_unit(bh >> 3, bh & 7, s, (const short*)(ws + WS_QB), (const short*)(ws + WS_KB), (const short*)(ws + WS_VB), (const float*)(ws + WS_ROPEC), (const float*)(ws + WS_ROPES), (short*)(ws + WS_O), (att::lptr)lds, wave); }
#endif
#ifndef DBG_NO_SWA
              for (int si = vcu; si < 512; si += G) { const int b = si >> 8, kvh = (si >> 6) & 3, n = si & 63;
                att::swa_unit(b, kvh, n, (const short*)(ws + WS_QA), (const short*)(ws + WS_KA), (const short*)(ws + WS_VA), ka_ptr<const int>(k, 2), KIN(k, 11) + l * 16, (short*)(ws + WS_O), (att::lptr)lds, wave); }
#endif
            }
            GRID_BAR();
            { const KArg k = ka_fresh(ka0); bf16* O = (bf16*)(ka_ptr<unsigned char>(k, KA_WS) + WS_O);
              const int ln_ = lane_id();
              const int mb_ = use_group ? (8 * (bxi % 8) + (bxi / 8) % 8) * 256 + (bxi >> 6) * 64 + wave * 8 : gw, me_ = use_group ? mb_ + 8 : MROWS, ms_ = use_group ? 1 : NGW;
              for (int m = mb_; m < me_; m += ms_) { const int half = ln_ >> 5, l32 = ln_ & 31; bf16* op = O + (size_t)m * DM + half * 1024 + l32 * 8;
                v4u w[4]; float s = 0.f;
#pragma unroll
                for (int j = 0; j < 4; ++j) { w[j] = *(const v4u*)(op + j * 256);
#pragma unroll
                    for (int e = 0; e < 4; ++e) { const float a = pg8::bf_lo(w[j][e]), b2 = pg8::bf_hi(w[j][e]); s += a * a + b2 * b2; } }
#pragma unroll
                for (int o = 1; o < 32; o <<= 1) s += __shfl_xor(s, o);
                const float r = pg8::rsq(s * (1.0f / 1024.0f) + EPS);
#pragma unroll
                for (int j = 0; j < 4; ++j) { v4u o;
#pragma unroll
                    for (int e = 0; e < 4; ++e) o[e] = pk2(pg8::bf_lo(w[j][e]) * r, pg8::bf_hi(w[j][e]) * r);
                    *(v4u*)(op + j * 256) = o; } } }
            GROUP_BAR();
            { const KArg k = ka_fresh(ka0); unsigned char* ws = ka_ptr<unsigned char>(k, KA_WS);
              pg8::Gemm g{(const bf16*)(ws + WS_O), (const bf16*)(ws + WS_W + (size_t)l * W_LAYER + W_O), MROWS, DM, DM}; pg8::StaticOrder S; S.init(MROWS, DM, Gi, bxi);
              pg8::EpiResid E{ka0, -1, 1.0f, WS_HB, WS_HB};
#if !defined(DBG_ONLY) || DBG_ONLY == 6
              pg8::gemm_phase<pg8::EpiResid, pg8::StaticOrder, true, true>(lds, g, S, E, wave);
#endif
            }
            GROUP_BAR();
        } else {
            { const KArg k = ka_fresh(ka0); unsigned char* ws = ka_ptr<unsigned char>(k, KA_WS);
              pg8::Gemm g{(const bf16*)(ws + WS_QA8), (const bf16*)(ws + WS_W + (size_t)l * W_LAYER + W_PG), MROWS, DM, DM / 2}; pg8::StaticOrder S; S.init(MROWS, DM, Gi, bxi);
              LAS float* rst = (LAS float*)(lds + RS_OFF); pg8::Unit u0; int nu_ = 0; (void)S.next(0, u0);
              const bool onepanel = quant_prepass(S, (const bf16*)(ws + WS_HB), ws, rst, (volatile LAS int*)nullptr, nu_, use_group, grp_local, bxi, gseq, wave);
              if (onepanel) { FILL_RS(rst + 256, ka_stats(k, (l & 1) ? (int)SS_PP2 : (int)SS_PP), u0.pm); }
              VM_WAIT(); __syncthreads();
              pg8::EpiPle E{ka0, l, onepanel ? (const LAS float*)rst : (const LAS float*)nullptr, WS_WSCP + (size_t)l * DM * 4, (l & 1) ? WS_PP2 : WS_PP, (l & 1) ? (int)SS_PP2 : (int)SS_PP};
#if !defined(DBG_ONLY) || DBG_ONLY == 7
              pg8::gemm_phase<pg8::EpiPle, pg8::StaticOrder, true, true, true>(lds, g, S, E, wave);
#endif
            }
            if (hl + 1 < 2 * DEPTH) GROUP_BAR();
        }
    }
}

extern "C" void kernel_launch(void* const* d_in, const int* in_sizes, int n_in, void* d_out, int out_size, void* d_ws, size_t ws_size, hipStream_t stream) {
    static int grid = 0;
    if (grid == 0) {
        if (n_in != 29 || out_size != MROWS * DM || ws_size < WS_END) { fprintf(stderr, "kernel_launch: unexpected shapes (n_in %d, out %d, ws %zu < %zu); nothing launched\n", n_in, out_size, ws_size, (size_t)WS_END); grid = -1; return; }
        int dev = 0, cus = 0, per_cu = 0;
        if (hipGetDevice(&dev) != hipSuccess || hipDeviceGetAttribute(&cus, hipDeviceAttributeMultiprocessorCount, dev) != hipSuccess) { grid = -1; return; }
        if (hipFuncSetAttribute((const void*)hybrid_fwd, hipFuncAttributeMaxDynamicSharedMemorySize, LDS_BYTES) != hipSuccess) { fprintf(stderr, "kernel_launch: hipFuncSetAttribute failed\n"); grid = -1; return; }
        if (hipOccupancyMaxActiveBlocksPerMultiprocessor(&per_cu, (const void*)hybrid_fwd, NWAVES * 64, LDS_BYTES) != hipSuccess || per_cu < 1)
            fprintf(stderr, "kernel_launch: note: occupancy query reports %d workgroups per CU\n", per_cu);
        (void)hipGetLastError();
        grid = cus;
    }
    if (grid < 0) return;
    if (hipMemsetAsync((char*)d_ws + WS_CTL, 0, ZERO_BYTES, stream) != hipSuccess) { fprintf(stderr, "kernel_launch: hipMemsetAsync failed\n"); return; }
    Args a{};
    for (int i = 0; i < 29; ++i) a.in[i] = d_in[i];
    a.out = (float*)d_out; a.ws = (unsigned char*)d_ws;
    hipLaunchKernelGGL(hybrid_fwd, dim3(grid), dim3(NWAVES * 64), LDS_BYTES, stream, a);
    const hipError_t le = hipPeekAtLastError();
    if (le != hipSuccess) fprintf(stderr, "kernel_launch: launch failed: %s\n", hipGetErrorName(le));
}
```
